# Optimizing an MI355X kernel written in HIP

```python
import jax, jax.numpy as jnp
from jax import lax
import numpy as np

D_MODEL = 1024
BATCH = 16
SEQ = 2048
DEPTH = 4
DEC_BATCH = 4
DEC_SEQ = 4096
PAST_LEN = 128

N_MEM = 256
D_FF = 2816
D_CONV = D_MODEL // 2
CONV_W = 3
GLA_HEADS = 4
D_GLA_V = D_MODEL // 2
HEAD_V = D_GLA_V // GLA_HEADS
D_GLA_K = D_GLA_V // 2
HEAD_K = D_GLA_K // GLA_HEADS
GATE_RANK = 16
GATE_TEMP = 16.0
GATE_BIAS_MEAN = 2.0
CHUNK = 64
XA_HEADS = 4
XA_HEAD_DIM = D_MODEL // XA_HEADS
LN_EPS = 1e-5
RMS_EPS = 1e-6
DN_ALPHA = (2 * DEPTH) ** 0.25
DN_BETA = (8 * DEPTH) ** -0.25

IN_SPLITS = (D_CONV, D_CONV, D_CONV, D_GLA_K, D_GLA_K, D_GLA_V, D_GLA_V, GATE_RANK, GATE_RANK, D_MODEL, D_MODEL)
IN_OFFSETS = tuple(int(o) for o in np.cumsum(IN_SPLITS)[:-1])
D_IN = int(sum(IN_SPLITS))

kernel_name = 'hybrid_conv_gla_memory_encoder'


def layer_norm(x, g, b):
    xf = x.astype(jnp.float32)
    mu = jnp.mean(xf, axis=-1, keepdims=True)
    var = jnp.mean(jnp.square(xf - mu), axis=-1, keepdims=True)
    return ((xf - mu) * lax.rsqrt(var + LN_EPS) * g.astype(jnp.float32) + b.astype(jnp.float32)).astype(x.dtype)


def swiglu(x, w_gu, w_down):
    gate, up = jnp.split(x @ w_gu, 2, axis=-1)
    return (jax.nn.silu(gate) * up) @ w_down


def short_conv(u, w):
    up = jnp.pad(u, ((0, 0), (1, 1), (0, 0)))
    return up[:, :-2] * w[0] + up[:, 1:-1] * w[1] + up[:, 2:] * w[2]


def gla_direction(q, k, v, log_a, include_diag):
    B, T, H, DK = q.shape
    DV = v.shape[-1]
    N = T // CHUNK
    f32 = jnp.float32
    qc = q.astype(f32).reshape(B, N, CHUNK, H, DK)
    kc = k.astype(f32).reshape(B, N, CHUNK, H, DK)
    vc = v.astype(f32).reshape(B, N, CHUNK, H, DV)
    b = jnp.cumsum(log_a.astype(f32).reshape(B, N, CHUNK, H, DK), axis=2)
    ref = b[:, :, CHUNK // 2 - 1:CHUNK // 2]
    q_in = qc * jnp.exp(b - ref)
    k_in = kc * jnp.exp(ref - b)
    mask = jnp.tril(jnp.ones((CHUNK, CHUNK), dtype=bool), 0 if include_diag else -1)
    att = jnp.where(mask, jnp.einsum('bnihd,bnjhd->bnhij', q_in, k_in), 0.0)
    o = jnp.einsum('bnhij,bnjhe->bnihe', att, vc)
    b_last = b[:, :, -1]
    kv = jnp.einsum('bnjhd,bnjhe->bnhde', kc * jnp.exp(b_last[:, :, None] - b), vc)

    def step(S, inp):
        kv_n, d_n = inp
        return d_n[..., None] * S + kv_n, S

    S0 = jnp.zeros((B, H, DK, DV), f32)
    _, S_prev = lax.scan(step, S0, (jnp.moveaxis(kv, 1, 0), jnp.moveaxis(jnp.exp(b_last), 1, 0)))
    S_prev = jnp.moveaxis(S_prev, 0, 1)
    o = o + jnp.einsum('bnihd,bnhde->bnihe', qc * jnp.exp(b), S_prev)
    return o.reshape(B, T, H, DV)


def parallel_mixer(x, w_in, conv_w, w_conv_out, gla_w2, gla_b, gla_norm_g, w_gla_out, w_out):
    B, T, _ = x.shape
    h, gb, gc, q, k, v, g, lr_f, lr_b, m_conv, m_gla = jnp.split(x @ w_in, IN_OFFSETS, axis=-1)
    y_conv = (gb * short_conv(gc * h, conv_w)) @ w_conv_out
    q = q.reshape(B, T, GLA_HEADS, HEAD_K) * (HEAD_K ** -0.5)
    k = k.reshape(B, T, GLA_HEADS, HEAD_K)
    v = v.reshape(B, T, GLA_HEADS, HEAD_V)
    log_a_f = (jax.nn.log_sigmoid((lr_f @ gla_w2[0] + gla_b[0]).astype(jnp.float32)) / GATE_TEMP).reshape(B, T, GLA_HEADS, HEAD_K)
    log_a_b = (jax.nn.log_sigmoid((lr_b @ gla_w2[1] + gla_b[1]).astype(jnp.float32)) / GATE_TEMP).reshape(B, T, GLA_HEADS, HEAD_K)
    o_f = gla_direction(q, k, v, log_a_f, True)
    o_b = jnp.flip(gla_direction(jnp.flip(q, 1), jnp.flip(k, 1), jnp.flip(v, 1), jnp.flip(log_a_b, 1), False), 1)
    o = o_f + o_b
    o = o * lax.rsqrt(jnp.mean(jnp.square(o), axis=-1, keepdims=True) + RMS_EPS) * gla_norm_g.astype(jnp.float32)
    o = o.astype(x.dtype).reshape(B, T, D_GLA_V) * jax.nn.silu(g)
    y_gla = o @ w_gla_out
    merged = jax.nn.sigmoid(m_conv) * y_conv + jax.nn.sigmoid(m_gla) * y_gla
    return merged @ w_out


def memory_cross_attention(x, mem, w_q, w_kv, w_o):
    B, T, _ = x.shape
    M = mem.shape[1]
    q = (x @ w_q).reshape(B, T, XA_HEADS, XA_HEAD_DIM)
    k, v = jnp.split(mem @ w_kv, 2, axis=-1)
    k = k.reshape(B, M, XA_HEADS, XA_HEAD_DIM)
    v = v.reshape(B, M, XA_HEADS, XA_HEAD_DIM)
    s = jnp.einsum('bthd,bmhd->bhtm', q, k).astype(jnp.float32) * (XA_HEAD_DIM ** -0.5)
    p = jax.nn.softmax(s, axis=-1).astype(v.dtype)
    o = jnp.einsum('bhtm,bmhd->bthd', p, v).reshape(B, T, D_MODEL)
    return o @ w_o


def trunk(x, mem, ffn1_w_gu, ffn1_w_down, w_mix_in, conv_w, w_conv_out, gla_gate_w2, gla_gate_b,
          gla_norm_g, w_gla_out, w_mix_out, xa_w_q, xa_w_kv, xa_w_o, ffn2_w_gu, ffn2_w_down, ln_g, ln_b):
    for l in range(DEPTH):
        x = layer_norm(DN_ALPHA * x + 0.5 * swiglu(x, ffn1_w_gu[l], ffn1_w_down[l]), ln_g[l, 0], ln_b[l, 0])
        x = layer_norm(DN_ALPHA * x + parallel_mixer(x, w_mix_in[l], conv_w[l], w_conv_out[l], gla_gate_w2[l],
                                                     gla_gate_b[l], gla_norm_g[l], w_gla_out[l], w_mix_out[l]),
                       ln_g[l, 1], ln_b[l, 1])
        x = layer_norm(DN_ALPHA * x + memory_cross_attention(x, mem, xa_w_q[l], xa_w_kv[l], xa_w_o[l]), ln_g[l, 2], ln_b[l, 2])
        x = layer_norm(DN_ALPHA * x + 0.5 * swiglu(x, ffn2_w_gu[l], ffn2_w_down[l]), ln_g[l, 3], ln_b[l, 3])
    return x


def _normal(key, shape, scale):
    return jax.random.normal(key, shape, jnp.float32) * scale


def setup_inputs(seed: int = 0) -> dict:
    key = jax.random.key(seed)
    ks = jax.random.split(key, 24)
    L = DEPTH
    return {
        'x_prompt': _normal(ks[0], (BATCH, SEQ, D_MODEL), 1.0),
        'x_sample': _normal(ks[1], (DEC_BATCH, DEC_SEQ, D_MODEL), 1.0),
        'mem_prompt': _normal(ks[2], (BATCH, N_MEM, D_MODEL), 1.0),
        'mem_sample': _normal(ks[3], (DEC_BATCH, N_MEM, D_MODEL), 1.0),
        'ffn1_w_gu': _normal(ks[4], (L, D_MODEL, 2 * D_FF), D_MODEL ** -0.5),
        'ffn1_w_down': _normal(ks[5], (L, D_FF, D_MODEL), DN_BETA * D_FF ** -0.5),
        'w_mix_in': _normal(ks[6], (L, D_MODEL, D_IN), D_MODEL ** -0.5),
        'conv_w': _normal(ks[7], (L, CONV_W, D_CONV), CONV_W ** -0.5),
        'w_conv_out': _normal(ks[8], (L, D_CONV, D_MODEL), D_CONV ** -0.5),
        'gla_gate_w2': _normal(ks[9], (L, 2, GATE_RANK, D_GLA_K), GATE_RANK ** -0.5),
        'gla_gate_b': GATE_BIAS_MEAN + _normal(ks[10], (L, 2, D_GLA_K), 0.1),
        'gla_norm_g': 1.0 + _normal(ks[11], (L, HEAD_V), 0.01),
        'w_gla_out': _normal(ks[12], (L, D_GLA_V, D_MODEL), D_GLA_V ** -0.5),
        'w_mix_out': _normal(ks[13], (L, D_MODEL, D_MODEL), DN_BETA * D_MODEL ** -0.5),
        'xa_w_q': _normal(ks[14], (L, D_MODEL, D_MODEL), D_MODEL ** -0.5),
        'xa_w_kv': _normal(ks[15], (L, D_MODEL, 2 * D_MODEL), D_MODEL ** -0.5),
        'xa_w_o': _normal(ks[16], (L, D_MODEL, D_MODEL), DN_BETA * D_MODEL ** -0.5),
        'ffn2_w_gu': _normal(ks[17], (L, D_MODEL, 2 * D_FF), D_MODEL ** -0.5),
        'ffn2_w_down': _normal(ks[18], (L, D_FF, D_MODEL), DN_BETA * D_FF ** -0.5),
        'ln_g': 1.0 + _normal(ks[19], (L, 4, D_MODEL), 0.01),
        'ln_b': _normal(ks[20], (L, 4, D_MODEL), 0.01),
    }


def reference(x_prompt, x_sample, mem_prompt, mem_sample, ffn1_w_gu, ffn1_w_down, w_mix_in, conv_w, w_conv_out,
              gla_gate_w2, gla_gate_b, gla_norm_g, w_gla_out, w_mix_out, xa_w_q, xa_w_kv, xa_w_o,
              ffn2_w_gu, ffn2_w_down, ln_g, ln_b):
    weights = (ffn1_w_gu, ffn1_w_down, w_mix_in, conv_w, w_conv_out, gla_gate_w2, gla_gate_b, gla_norm_g,
               w_gla_out, w_mix_out, xa_w_q, xa_w_kv, xa_w_o, ffn2_w_gu, ffn2_w_down, ln_g, ln_b)
    y_prompt = trunk(x_prompt, mem_prompt, *weights)
    y_sample = trunk(x_sample, mem_sample, *weights)
    return (y_prompt, y_sample)
```

```cpp
#include <hip/hip_runtime.h>
#include <hip/hip_cooperative_groups.h>
#include <cstdio>
namespace cg = cooperative_groups;
namespace pg8 {
#define PG8_LAS __attribute__((address_space(3)))
typedef unsigned short bf16_t;
typedef short bf16x8 __attribute__((ext_vector_type(8)));
typedef float f32x4 __attribute__((ext_vector_type(4)));
typedef unsigned u32x4 __attribute__((ext_vector_type(4)));
constexpr int BM = 256, BK = 64, HALF = 128, HTB = HALF * BK * 2  , STAGE_BYTES = 8 * HTB, NXCD = 8, WGM = 8;

__host__ __device__ __forceinline__ int lds_byte(int r, int c) { const int st = (r >> 4) * 2 + (c >> 5), rr = r & 15, cc = c & 31, ob = rr * 64 + cc * 2; return st * 1024 + (ob ^ (((ob >> 9) & 1) << 5)); }
__host__ __device__ __forceinline__ void stage_rc(int b, int& R, int& C) { const int st = b / 1024, sb = b % 1024, swz = sb ^ (((sb >> 9) & 1) << 5); R = (st >> 1) * 16 + swz / 64; C = (st & 1) * 32 + (swz % 64) / 2; }
__host__ __device__ __forceinline__ int perm32(int rho) { const int n = rho >> 4, i = rho & 15; return 8 * (i >> 2) + 4 * n + (i & 3); }

struct Unit { int pm, pn; };
struct Gemm { const bf16_t* A; const bf16_t* Bt; int M, N, K; };

struct StaticOrder {
    int nM, nN, nwg, G, c;
    __host__ __device__ void init(int M, int N, int G_, int c_) { nM = M / BM; nN = N / BM; nwg = nM * nN; G = G_; c = c_; }
    __host__ __device__ bool next(int i, Unit& u) const {
        const long L = (long)i * G + c; if (L >= nwg) return false;
        int wgid = (int)L; { const int q = nwg / NXCD, r = nwg % NXCD, xcd = wgid % NXCD, off = wgid / NXCD; wgid = (xcd < r ? xcd * (q + 1) : r * (q + 1) + (xcd - r) * q) + off; }
        const int nig = WGM * nN, gid = wgid / nig, fm = gid * WGM, gsz = (nM - fm) < WGM ? (nM - fm) : WGM;
        u.pm = fm + ((wgid % nig) % gsz); u.pn = (wgid % nig) / gsz; return true;
    }
    __device__ __forceinline__ void a_ready(const Unit&) const {}
    __device__ __forceinline__ void done(const Unit&) const {}
};
struct CountedOrder : StaticOrder {
    const unsigned* ready; unsigned need; unsigned* tmo;
    __device__ __forceinline__ void a_ready(const Unit& u) const {
        if (threadIdx.x < 64) {
            const unsigned long long t0 = __builtin_amdgcn_s_memrealtime(); unsigned polls = 0;
            while ((unsigned)__builtin_amdgcn_readfirstlane(__hip_atomic_load(ready + 64 * u.pm, __ATOMIC_RELAXED, __HIP_MEMORY_SCOPE_AGENT)) < need) {
                if ((++polls & 255u) == 0u && __builtin_amdgcn_readfirstlane(__hip_atomic_load(tmo, __ATOMIC_RELAXED, __HIP_MEMORY_SCOPE_AGENT)) != 0u) break;
                if (__builtin_amdgcn_s_memrealtime() - t0 > 2000000ull) {
                    if (threadIdx.x == 0) { unsigned expect = 0u; __hip_atomic_compare_exchange_strong(tmo + 1, &expect, 0x600u | (unsigned)(u.pm & 0xff), __ATOMIC_RELAXED, __ATOMIC_RELAXED, __HIP_MEMORY_SCOPE_AGENT); __hip_atomic_store(tmo, 1u, __ATOMIC_RELAXED, __HIP_MEMORY_SCOPE_AGENT); }
                    break; }
                __builtin_amdgcn_s_sleep(2); }
            __builtin_amdgcn_fence(__ATOMIC_ACQUIRE, "agent");
            asm volatile("s_waitcnt vmcnt(0)" ::: "memory");
        }
#if !defined(BROKEN_HOOK_NO_BARRIER)
        asm volatile("" ::: "memory"); __builtin_amdgcn_s_barrier(); asm volatile("" ::: "memory");
#endif
    }
};

__device__ __forceinline__ unsigned cvt_pk_bf16(float lo, float hi) { unsigned r; asm volatile("v_cvt_pk_bf16_f32 %0, %1, %2" : "=v"(r) : "v"(lo), "v"(hi)); return r; }
typedef float f32x2 __attribute__((ext_vector_type(2)));
__device__ __forceinline__ f32x2 gelu_pk(f32x2 v) {
    const f32x2 av = __builtin_elementwise_abs(v), d = av * 0.2316418882f + 1.0f;
    f32x2 t; t.x = __builtin_amdgcn_rcpf(d.x); t.y = __builtin_amdgcn_rcpf(d.y);
    f32x2 q = t * 0.5307027145f + (-0.7265760135f); q = q * t + 0.7107068705f; q = q * t + (-0.142248368f); q = q * t + 0.127414796f; q = q * t;
    const f32x2 s = (v * v) * (-0.72134752044f);
    f32x2 e; e.x = __builtin_amdgcn_exp2f(s.x); e.y = __builtin_amdgcn_exp2f(s.y);
    const f32x2 m = v * (q * e), r = v - m;
    f32x2 o; o.x = v.x < 0.f ? m.x : r.x; o.y = v.y < 0.f ? m.y : r.y; return o;
}

struct EpiF32 {
    static constexpr bool PERM = false, AFTER_DRAIN = false;
    float* C; int ldc; const float* bias;
    __device__ __forceinline__ void operator()(const f32x4 (&acc)[2][2][4][2], const Unit& u, int wr, int wc, int fr, int fq) const {
        const int row0 = u.pm * BM + wr * 64 + fr, col0 = u.pn * BM + wc * 32 + 4 * fq;
        f32x4 bv[2][2];
#pragma unroll
        for (int bj = 0; bj < 2; ++bj)
#pragma unroll
            for (int n = 0; n < 2; ++n) bv[bj][n] = bias ? *(const f32x4*)(bias + col0 + bj * HALF + n * 16) : (f32x4){0.f, 0.f, 0.f, 0.f};
#pragma unroll
        for (int ai = 0; ai < 2; ++ai)
#pragma unroll
            for (int m = 0; m < 4; ++m) { float* rowp = C + (size_t)(row0 + ai * HALF + m * 16) * ldc + col0;
#pragma unroll
                for (int bj = 0; bj < 2; ++bj)
#pragma unroll
                    for (int n = 0; n < 2; ++n) *(f32x4*)(rowp + bj * HALF + n * 16) = acc[ai][bj][m][n] + bv[bj][n]; }
    }
};
template <int ACT  > struct EpiBf16 {
    static constexpr bool PERM = true, AFTER_DRAIN = false;
    bf16_t* O; int ldc; const float* bias; int split_cols; size_t split_stride;
    __device__ __forceinline__ void operator()(const f32x4 (&acc)[2][2][4][2], const Unit& u, int wr, int wc, int fr, int fq) const {
        const int row0 = u.pm * BM + wr * 64 + fr; int colt = u.pn * BM; bf16_t* base = O;
        if (split_cols) { const int t = colt / split_cols; base += (size_t)t * split_stride; colt -= t * split_cols; }
        const int col0 = colt + wc * 32 + 8 * fq, bcol0 = u.pn * BM + wc * 32 + 8 * fq;
        f32x4 bv[2][2];
#pragma unroll
        for (int bj = 0; bj < 2; ++bj)
#pragma unroll
            for (int n = 0; n < 2; ++n) bv[bj][n] = bias ? *(const f32x4*)(bias + bcol0 + bj * HALF + 4 * n) : (f32x4){0.f, 0.f, 0.f, 0.f};
#pragma unroll
        for (int ai = 0; ai < 2; ++ai)
#pragma unroll
            for (int m = 0; m < 4; ++m) { bf16_t* rowp = base + (size_t)(row0 + ai * HALF + m * 16) * ldc + col0;
#pragma unroll
                for (int bj = 0; bj < 2; ++bj) { f32x4 v0 = acc[ai][bj][m][0] + bv[bj][0], v1 = acc[ai][bj][m][1] + bv[bj][1];
                    if (ACT == 1) { f32x2 a = gelu_pk((f32x2){v0[0], v0[1]}), b = gelu_pk((f32x2){v0[2], v0[3]}), c = gelu_pk((f32x2){v1[0], v1[1]}), d = gelu_pk((f32x2){v1[2], v1[3]});
                        v0 = (f32x4){a.x, a.y, b.x, b.y}; v1 = (f32x4){c.x, c.y, d.x, d.y}; }
                    if (ACT == 2) {
#pragma unroll
                        for (int j = 0; j < 4; ++j) { v0[j] = 0.5f * v0[j] * (1.0f + erff(v0[j] * 0.70710678f)); v1[j] = 0.5f * v1[j] * (1.0f + erff(v1[j] * 0.70710678f)); } }
                    u32x4 w; w.x = cvt_pk_bf16(v0[0], v0[1]); w.y = cvt_pk_bf16(v0[2], v0[3]); w.z = cvt_pk_bf16(v1[0], v1[1]); w.w = cvt_pk_bf16(v1[2], v1[3]);
                    *(u32x4*)(rowp + bj * HALF) = w; } }
    }
};

struct PanelStats {
    unsigned* xbuf;
    unsigned* cnt;
    unsigned* tmo;
    int ntn; float eps;
    unsigned code;
    __device__ __forceinline__ bool run(const f32x4 (&v)[2][2][4][2], const Unit& u, int wr, int wc, int fr, int fq, PG8_LAS unsigned char* lds, int wid, int lane) const {
        typedef float f32x2v __attribute__((ext_vector_type(2)));
        PG8_LAS f32x2v* P = (PG8_LAS f32x2v*)lds;
        PG8_LAS f32x2v* S = (PG8_LAS f32x2v*)(lds + 8192);
        PG8_LAS unsigned* flag = (PG8_LAS unsigned*)(lds + 8192 + 2048);
#pragma unroll
        for (int ai = 0; ai < 2; ++ai)
#pragma unroll
            for (int m = 0; m < 4; ++m) {
                float s = 0.f;
#pragma unroll
                for (int bj = 0; bj < 2; ++bj)
#pragma unroll
                    for (int n = 0; n < 2; ++n) { const f32x4 x = v[ai][bj][m][n]; s += (x[0] + x[1]) + (x[2] + x[3]); }
                s += __shfl_xor(s, 16); s += __shfl_xor(s, 32);
                const float mw = s * (1.0f / 64.0f); float q = 0.f;
#pragma unroll
                for (int bj = 0; bj < 2; ++bj)
#pragma unroll
                    for (int n = 0; n < 2; ++n) { const f32x4 d = v[ai][bj][m][n] - mw; q += (d[0] * d[0] + d[1] * d[1]) + (d[2] * d[2] + d[3] * d[3]); }
                q += __shfl_xor(q, 16); q += __shfl_xor(q, 32);
                if (fq == 0) P[(ai * HALF + wr * 64 + m * 16 + fr) * 4 + wc] = (f32x2v){mw, q};
            }
        asm volatile("s_waitcnt lgkmcnt(0)" ::: "memory"); __builtin_amdgcn_s_barrier(); asm volatile("" ::: "memory");
#if defined(BROKEN_NO_WAIT)
        if (blockIdx.x >= 64) { const long long t0 = clock64(); while (clock64() - t0 < 60000) __builtin_amdgcn_s_sleep(8); }
#endif
        const int row = wid * 32 + (lane & 31);
        if (lane < 32) {
            const f32x2v a = P[row * 4 + 0], b = P[row * 4 + 1], c = P[row * 4 + 2], d = P[row * 4 + 3];
            const float mt = (a.x + b.x + c.x + d.x) * 0.25f;
            const float da = a.x - mt, db = b.x - mt, dc = c.x - mt, dd = d.x - mt;
            const float m2 = (a.y + b.y) + (c.y + d.y) + 64.0f * ((da * da + db * db) + (dc * dc + dd * dd));
            unsigned long long* slot = (unsigned long long*)xbuf + ((size_t)(u.pm * BM + row) * 4 + u.pn);
            __hip_atomic_store(slot, ((unsigned long long)__float_as_uint(m2) << 32) | __float_as_uint(mt), __ATOMIC_RELAXED, __HIP_MEMORY_SCOPE_AGENT);
        }
        asm volatile("s_waitcnt vmcnt(0)" ::: "memory");
        if (lane == 0) __hip_atomic_fetch_add(cnt + 64 * u.pm, 1u, __ATOMIC_RELAXED, __HIP_MEMORY_SCOPE_AGENT);
        if (wid == 0) {
            bool dead = false; const unsigned long long t0 = __builtin_amdgcn_s_memrealtime(); const unsigned want = 8u * (unsigned)ntn;
            for (;;) {
#if defined(BROKEN_NO_WAIT)
                break;
#endif
                if ((unsigned)__builtin_amdgcn_readfirstlane(__hip_atomic_load(cnt + 64 * u.pm, __ATOMIC_RELAXED, __HIP_MEMORY_SCOPE_AGENT)) >= want) break;
                if (__builtin_amdgcn_s_memrealtime() - t0 > 2000000ull) {
                    if (lane == 0) { unsigned expect = 0u; __hip_atomic_compare_exchange_strong(tmo + 1, &expect, code | (unsigned)(u.pm & 0xff), __ATOMIC_RELAXED, __ATOMIC_RELAXED, __HIP_MEMORY_SCOPE_AGENT);
                                     __hip_atomic_store(tmo, 1u, __ATOMIC_RELAXED, __HIP_MEMORY_SCOPE_AGENT); }
                    dead = true; break; }
                __builtin_amdgcn_s_sleep(2);
            }
            __builtin_amdgcn_fence(__ATOMIC_ACQUIRE, "agent");
            if (lane == 0) flag[0] = dead ? 1u : 0u;
        }
        asm volatile("s_waitcnt vmcnt(0) lgkmcnt(0)" ::: "memory"); __builtin_amdgcn_s_barrier(); asm volatile("" ::: "memory");
        const bool bad = flag[0] != 0u;
        if (lane < 32) {
            const unsigned long long* slot = (const unsigned long long*)xbuf + (size_t)(u.pm * BM + row) * 4; float mt[4], m2[4]; float ms = 0.f;
#pragma unroll
            for (int t = 0; t < 4; ++t) { if (t < ntn) { const unsigned long long w = __hip_atomic_load(slot + t, __ATOMIC_RELAXED, __HIP_MEMORY_SCOPE_AGENT); mt[t] = __uint_as_float((unsigned)w); m2[t] = __uint_as_float((unsigned)(w >> 32)); } else { mt[t] = 0.f; m2[t] = 0.f; } ms += mt[t]; }
            const float mean = ms / (float)ntn; float q = 0.f;
#pragma unroll
            for (int t = 0; t < 4; ++t) if (t < ntn) { const float dm = mt[t] - mean; q += m2[t] + 256.0f * dm * dm; }
            S[row] = (f32x2v){mean, 1.0f / sqrtf(q / (256.0f * (float)ntn) + eps)};
        }
        asm volatile("s_waitcnt lgkmcnt(0)" ::: "memory"); __builtin_amdgcn_s_barrier(); asm volatile("" ::: "memory");
        return bad;
    }
};
struct EpiLnRes {
    static constexpr bool PERM = false, AFTER_DRAIN = true;
    const float* base; float* out; int ldc; const float* bias; PanelStats st; unsigned poison;
    __device__ __forceinline__ void refuse(size_t i0, size_t stride, int M, int N) const { const float q = __builtin_nanf(""); for (size_t i = i0; i < (size_t)M * N; i += stride) out[(i / N) * ldc + i % N] = q;
        if (i0 == 0) { unsigned expect = 0u; __hip_atomic_compare_exchange_strong(st.tmo + 1, &expect, 0x7f0u, __ATOMIC_RELAXED, __ATOMIC_RELAXED, __HIP_MEMORY_SCOPE_AGENT); __hip_atomic_store(st.tmo, 1u, __ATOMIC_RELAXED, __HIP_MEMORY_SCOPE_AGENT); } }
    __device__ __forceinline__ void fused(f32x4 (&acc)[2][2][4][2], const Unit& u, int wr, int wc, int fr, int fq, PG8_LAS unsigned char* lds, int wid, int lane) const {
        typedef float f32x2v __attribute__((ext_vector_type(2)));
        const PG8_LAS f32x2v* S = (const PG8_LAS f32x2v*)(lds + 8192);
        const int col0 = u.pn * BM + wc * 32 + 4 * fq;
#pragma unroll
        for (int bj = 0; bj < 2; ++bj)
#pragma unroll
            for (int n = 0; n < 2; ++n) { const f32x4 bv = bias ? *(const f32x4*)(bias + col0 + bj * HALF + n * 16) : (f32x4){0.f, 0.f, 0.f, 0.f};
#pragma unroll
                for (int ai = 0; ai < 2; ++ai)
#pragma unroll
                    for (int m = 0; m < 4; ++m) acc[ai][bj][m][n] += bv; }
        const bool bad = st.run(acc, u, wr, wc, fr, fq, lds, wid, lane) || poison != 0u;
        const float qnan = __builtin_nanf("");
#pragma unroll
        for (int ai = 0; ai < 2; ++ai)
#pragma unroll
            for (int m = 0; m < 4; ++m) { const int r = ai * HALF + wr * 64 + m * 16 + fr; const f32x2v sr = S[r]; const size_t off = (size_t)(u.pm * BM + r) * ldc + col0;
#pragma unroll
                for (int bj = 0; bj < 2; ++bj)
#pragma unroll
                    for (int n = 0; n < 2; ++n) { const f32x4 bs = *(const f32x4*)(base + off + bj * HALF + n * 16); f32x4 o = bs + (acc[ai][bj][m][n] - sr.x) * sr.y;
                        if (bad) o = (f32x4){qnan, qnan, qnan, qnan}; *(f32x4*)(out + off + bj * HALF + n * 16) = o; }
                asm volatile("" ::: "memory"); }
    }
};
struct EpiLnResLn {
    static constexpr bool PERM = false, AFTER_DRAIN = true;
    const float* base; float* out; bf16_t* xn; int ldc; const float* bias; PanelStats st1, st2; unsigned poison;
    __device__ __forceinline__ void refuse(size_t i0, size_t stride, int M, int N) const { const float q = __builtin_nanf(""); for (size_t i = i0; i < (size_t)M * N; i += stride) { const size_t o = (i / N) * ldc + i % N; out[o] = q; xn[o] = (bf16_t)0x7fc0u; }
        if (i0 == 0) { unsigned expect = 0u; __hip_atomic_compare_exchange_strong(st1.tmo + 1, &expect, 0x7f0u, __ATOMIC_RELAXED, __ATOMIC_RELAXED, __HIP_MEMORY_SCOPE_AGENT); __hip_atomic_store(st1.tmo, 1u, __ATOMIC_RELAXED, __HIP_MEMORY_SCOPE_AGENT); } }
    __device__ __forceinline__ void fused(f32x4 (&acc)[2][2][4][2], const Unit& u, int wr, int wc, int fr, int fq, PG8_LAS unsigned char* lds, int wid, int lane) const {
        typedef float f32x2v __attribute__((ext_vector_type(2))); typedef unsigned u32x2v __attribute__((ext_vector_type(2)));
        const PG8_LAS f32x2v* S = (const PG8_LAS f32x2v*)(lds + 8192);
        const int col0 = u.pn * BM + wc * 32 + 4 * fq;
#pragma unroll
        for (int bj = 0; bj < 2; ++bj)
#pragma unroll
            for (int n = 0; n < 2; ++n) { const f32x4 bv = bias ? *(const f32x4*)(bias + col0 + bj * HALF + n * 16) : (f32x4){0.f, 0.f, 0.f, 0.f};
#pragma unroll
                for (int ai = 0; ai < 2; ++ai)
#pragma unroll
                    for (int m = 0; m < 4; ++m) acc[ai][bj][m][n] += bv; }
        bool bad = st1.run(acc, u, wr, wc, fr, fq, lds, wid, lane) || poison != 0u;
        const float qnan = __builtin_nanf("");
#pragma unroll
        for (int ai = 0; ai < 2; ++ai)
#pragma unroll
            for (int m = 0; m < 4; ++m) { const int r = ai * HALF + wr * 64 + m * 16 + fr; const f32x2v sr = S[r]; const size_t off = (size_t)(u.pm * BM + r) * ldc + col0;
#pragma unroll
                for (int bj = 0; bj < 2; ++bj)
#pragma unroll
                    for (int n = 0; n < 2; ++n) { const f32x4 bs = *(const f32x4*)(base + off + bj * HALF + n * 16); acc[ai][bj][m][n] = bs + (acc[ai][bj][m][n] - sr.x) * sr.y; }
                asm volatile("" : "+v"(acc[ai][0][m][0]), "+v"(acc[ai][0][m][1]), "+v"(acc[ai][1][m][0]), "+v"(acc[ai][1][m][1]));
                if (m & 1) asm volatile("" ::: "memory"); }
        const bool bad1 = bad;
        bad = st2.run(acc, u, wr, wc, fr, fq, lds, wid, lane) || bad;
#pragma unroll
        for (int ai = 0; ai < 2; ++ai)
#pragma unroll
            for (int m = 0; m < 4; ++m) { const int r = ai * HALF + wr * 64 + m * 16 + fr; const f32x2v sr = S[r]; const size_t off = (size_t)(u.pm * BM + r) * ldc + col0;
#pragma unroll
                for (int bj = 0; bj < 2; ++bj)
#pragma unroll
                    for (int n = 0; n < 2; ++n) { const f32x4 x1 = acc[ai][bj][m][n]; *(f32x4*)(out + off + bj * HALF + n * 16) = bad1 ? (f32x4){qnan, qnan, qnan, qnan} : x1;
                        const f32x4 o = (x1 - sr.x) * sr.y; u32x2v w; w.x = cvt_pk_bf16(o[0], o[1]); w.y = cvt_pk_bf16(o[2], o[3]);
                        if (bad) { w.x = 0x7fc07fc0u; w.y = 0x7fc07fc0u; } *(u32x2v*)(xn + off + bj * HALF + n * 16) = w; }
                asm volatile("" ::: "memory"); }
    }
};

template <class Epi, class Sched, bool STAMP = false>
__device__ __forceinline__ void gemm_phase(PG8_LAS unsigned char* lds, const Gemm g, const Sched& S, const Epi& E, unsigned long long* stamps) {
    int tid = threadIdx.x; asm volatile("" : "+v"(tid)); const int wid = __builtin_amdgcn_readfirstlane(tid >> 6), lane = tid & 63, wr = wid >> 2, wc = wid & 3, fr = lane & 15, fq = lane >> 4;
    const int K = g.K, nt = K / BK;
    int ts_lo = 0, ts_hi = 0, nts = 0; const unsigned long long rt_entry = STAMP ? (unsigned long long)wall_clock64() : 0ull;
#define PG8_STAMP() do { if (STAMP && wid == 0 && nts < 64) { const unsigned long long _c = (unsigned long long)clock64(); \
        ts_lo = (lane == nts) ? (int)(unsigned)_c : ts_lo; ts_hi = (lane == nts) ? (int)(unsigned)(_c >> 32) : ts_hi; ++nts; } } while (0)
    PG8_STAMP();
    unsigned voffA[2], voffB[2];
#pragma unroll
    for (int i = 0; i < 2; ++i) { int R, C; stage_rc(tid * 16 + i * 8192, R, C); const int Rb = Epi::PERM ? ((R & ~31) + perm32(R & 31)) : R;
        voffA[i] = (unsigned)(R * K + C) * 2u; voffB[i] = (unsigned)(Rb * K + C) * 2u; }
    const size_t kstep = (size_t)(BK * 2);
    const size_t hstep = (size_t)HALF * K * 2;
    const size_t tstep = 2 * hstep;
    const unsigned ldsw = (unsigned)wid * 1024u;
    const int aoff = lds_byte(wr * 64 + fr, fq * 8), boff = lds_byte(wc * 32 + fr, fq * 8);
#define PG8_SA(b, h) (((b) * 2 + (h)) * HTB)
#define PG8_SB(b, h) ((4 + (b) * 2 + (h)) * HTB)
#define PG8_STAGE(bufoff, gbase, voff) do { _Pragma("unroll") for (int _i = 0; _i < 2; ++_i) \
        __builtin_amdgcn_global_load_lds((const unsigned*)((const char*)(gbase) + (voff)[_i]), (PG8_LAS unsigned*)(lds + (bufoff) + ldsw + _i * 8192), 16, 0, 0); } while (0)
#define PG8_LDA(dst, b, h) do { _Pragma("unroll") for (int m = 0; m < 4; ++m) _Pragma("unroll") for (int k = 0; k < 2; ++k) dst[m][k] = *(const PG8_LAS bf16x8*)(lds + PG8_SA(b, h) + aoff + m * 2048 + k * 1024); } while (0)
#define PG8_LDB(dst, b, h) do { _Pragma("unroll") for (int n = 0; n < 2; ++n) _Pragma("unroll") for (int k = 0; k < 2; ++k) dst[n][k] = *(const PG8_LAS bf16x8*)(lds + PG8_SB(b, h) + boff + n * 2048 + k * 1024); } while (0)
#define PG8_MMA(ai, bj, At, Bt) do { __builtin_amdgcn_s_setprio(1); _Pragma("unroll") for (int m = 0; m < 4; ++m) _Pragma("unroll") for (int n = 0; n < 2; ++n) _Pragma("unroll") for (int k = 0; k < 2; ++k) \
        acc[ai][bj][m][n] = __builtin_amdgcn_mfma_f32_16x16x32_bf16(Bt[n][k], At[m][k], acc[ai][bj][m][n], 0, 0, 0); __builtin_amdgcn_s_setprio(0); } while (0)
#define PG8_WAIT_V(n) asm volatile("s_waitcnt vmcnt(" #n ")" ::: "memory")
#define PG8_WAIT_L(n) asm volatile("s_waitcnt lgkmcnt(" #n ")" ::: "memory")
#define PG8_BAR __builtin_amdgcn_s_barrier()
#define PG8_SCHED __builtin_amdgcn_sched_barrier(0)
    Unit cur, nxt; int ui = 0;
    if (!S.next(0, cur)) return;
    f32x4 acc[2][2][4][2];
#pragma unroll
    for (int a = 0; a < 2; ++a)
#pragma unroll
        for (int b = 0; b < 2; ++b)
#pragma unroll
            for (int m = 0; m < 4; ++m)
#pragma unroll
                for (int n = 0; n < 2; ++n) acc[a][b][m][n] = (f32x4){0.f, 0.f, 0.f, 0.f};
    bf16x8 At[4][2], B0[2][2], B1[2][2];
    const char* cA = (const char*)g.A + (size_t)cur.pm * tstep; const char* cB = (const char*)g.Bt + (size_t)cur.pn * tstep;
    S.a_ready(cur);
    PG8_STAGE(PG8_SB(0, 0), cB, voffB); PG8_STAGE(PG8_SA(0, 0), cA, voffA); PG8_STAGE(PG8_SB(0, 1), cB + hstep, voffB); PG8_STAGE(PG8_SA(0, 1), cA + hstep, voffA);
    if (wr == 1) PG8_BAR;
    PG8_WAIT_V(4); PG8_BAR;
    PG8_STAGE(PG8_SB(1, 0), cB + kstep, voffB); PG8_STAGE(PG8_SA(1, 0), cA + kstep, voffA); PG8_STAGE(PG8_SB(1, 1), cB + hstep + kstep, voffB);
    PG8_WAIT_V(6); PG8_BAR;
    PG8_STAMP();
    for (;;) {
        const bool has_next = S.next(ui + 1, nxt);
        const char* nA = has_next ? (const char*)g.A + (size_t)nxt.pm * tstep : cA; const char* nB = has_next ? (const char*)g.Bt + (size_t)nxt.pn * tstep : cB;
        for (int t = 0; t < nt; t += 2) {
            const bool last = (t == nt - 2);
            const char* a1 = cA + (size_t)(t + 1) * kstep;
            const char* a2 = last ? nA : cA + (size_t)(t + 2) * kstep; const char* b2 = last ? nB : cB + (size_t)(t + 2) * kstep;
            const char* a3 = a2 + kstep; const char* b3 = b2 + kstep;
            if (last && has_next) S.a_ready(nxt);
            PG8_LDB(B0, 0, 0); PG8_SCHED; PG8_LDA(At, 0, 0); PG8_STAGE(PG8_SA(1, 1), a1 + hstep, voffA);
            PG8_WAIT_L(8); PG8_BAR; PG8_WAIT_L(0); PG8_MMA(0, 0, At, B0); PG8_BAR; PG8_SCHED;
            PG8_LDB(B1, 0, 1); PG8_STAGE(PG8_SB(0, 0), b2, voffB);
            PG8_BAR; PG8_WAIT_L(0); PG8_MMA(0, 1, At, B1); PG8_BAR;
            PG8_LDA(At, 0, 1); PG8_STAGE(PG8_SA(0, 0), a2, voffA);
            PG8_BAR; PG8_WAIT_L(0); PG8_MMA(1, 0, At, B0); PG8_BAR; PG8_SCHED;
            PG8_STAGE(PG8_SB(0, 1), b2 + hstep, voffB);
            PG8_WAIT_V(6); PG8_BAR; PG8_MMA(1, 1, At, B1); PG8_BAR;
            PG8_LDB(B0, 1, 0); PG8_SCHED; PG8_LDA(At, 1, 0); PG8_STAGE(PG8_SA(0, 1), a2 + hstep, voffA);
            PG8_WAIT_L(8); PG8_BAR; PG8_WAIT_L(0); PG8_MMA(0, 0, At, B0); PG8_BAR; PG8_SCHED;
            PG8_LDB(B1, 1, 1); PG8_STAGE(PG8_SB(1, 0), b3, voffB);
            PG8_BAR; PG8_WAIT_L(0); PG8_MMA(0, 1, At, B1); PG8_BAR;
            PG8_LDA(At, 1, 1); PG8_STAGE(PG8_SA(1, 0), a3, voffA);
            PG8_BAR; PG8_WAIT_L(0); PG8_MMA(1, 0, At, B0); PG8_BAR; PG8_SCHED;
            PG8_STAGE(PG8_SB(1, 1), b3 + hstep, voffB);
            PG8_WAIT_V(6); PG8_BAR; PG8_MMA(1, 1, At, B1); PG8_BAR;
        }
        PG8_STAMP();
        if constexpr (!Epi::AFTER_DRAIN) { E(acc, cur, wr, wc, fr, fq); S.done(cur); }
        PG8_STAMP();
        if (!has_next) break;
#pragma unroll
        for (int a = 0; a < 2; ++a)
#pragma unroll
            for (int b = 0; b < 2; ++b)
#pragma unroll
                for (int m = 0; m < 4; ++m)
#pragma unroll
                    for (int n = 0; n < 2; ++n) acc[a][b][m][n] = (f32x4){0.f, 0.f, 0.f, 0.f};
        cur = nxt; cA = nA; cB = nB; ++ui;
    }
    PG8_WAIT_V(0);
    if (wr == 0) PG8_BAR;
    PG8_BAR;
    if constexpr (Epi::AFTER_DRAIN) { E.fused(acc, cur, wr, wc, fr, fq, lds, wid, lane); S.done(cur); }
    PG8_STAMP();
    if (STAMP && wid == 0) { stamps[lane] = lane < nts ? (((unsigned long long)(unsigned)ts_hi << 32) | (unsigned)ts_lo) : 0ull;
        if (lane == 62) stamps[62] = rt_entry; if (lane == 63) stamps[63] = (unsigned long long)wall_clock64(); }
#undef PG8_STAMP
#undef PG8_SA
#undef PG8_SB
#undef PG8_STAGE
#undef PG8_LDA
#undef PG8_LDB
#undef PG8_MMA
#undef PG8_WAIT_V
#undef PG8_WAIT_L
#undef PG8_BAR
#undef PG8_SCHED
}
}

namespace mk {
using pg8::bf16_t; using pg8::bf16x8; using pg8::f32x4; using pg8::u32x4; using pg8::Unit; using pg8::cvt_pk_bf16;
typedef unsigned u32x2 __attribute__((ext_vector_type(2)));
typedef PG8_LAS float* ldsf;
constexpr int M = 49152, MP = 32768, D = 1024, DFF = 2816, NMEM = 5120, NL = 4, NPH = 17;
constexpr float ALPHA = 1.6817928305074292f;
constexpr int LDS_BYTES = 147456;

constexpr size_t W_GU1 = 0, W_D1 = W_GU1 + 5632ull * 1024, W_INA = W_D1 + 1024ull * 2816, W_INM = W_INA + 3328ull * 1024, W_CO = W_INM + 2048ull * 1024,
                 W_GO = W_CO + 1024ull * 512, W_OUT = W_GO + 1024ull * 512, W_Q = W_OUT + 1024ull * 1024, W_K = W_Q + 1024ull * 1024, W_V = W_K + 1024ull * 1024,
                 W_O = W_V + 1024ull * 1024, W_GU2 = W_O + 1024ull * 1024, W_D2 = W_GU2 + 5632ull * 1024, W_END = W_D2 + 1024ull * 2816;
constexpr size_t SZ512 = (size_t)M * 512 * 2;
constexpr size_t OFF_W = 4096, OFF_XB = OFF_W + W_END * 2, OFF_HC = OFF_XB + (size_t)M * 1024 * 2, OFF_GB = OFF_HC + SZ512, OFF_GC = OFF_GB + SZ512,
                 OFF_QK = OFF_GC + SZ512, OFF_V = OFF_QK + SZ512, OFF_G = OFF_V + SZ512, OFF_LR = OFF_G + SZ512, OFF_OF = OFF_LR + (size_t)M * 32 * 4,
                 OFF_AGLA = OFF_OF + (size_t)M * 512 * 4, OFF_MEMB = OFF_AGLA + SZ512, OFF_KM = OFF_MEMB + (size_t)NMEM * 1024 * 2, OFF_VT = OFF_KM + (size_t)NMEM * 1024 * 2,
                 WS_END = OFF_VT + (size_t)NMEM * 1024 * 2;

struct Params {
    const float* in[21];
    float* out; unsigned char* ws;
    int ph_lo, ph_hi, coop, pad;
};

__device__ __forceinline__ float bf_lo(unsigned w) { return __uint_as_float(w << 16); }
__device__ __forceinline__ float bf_hi(unsigned w) { return __uint_as_float(w & 0xffff0000u); }
__device__ __forceinline__ float bf2f(bf16_t b) { return __uint_as_float(((unsigned)b) << 16); }
__device__ __forceinline__ float sigm(float x) { return 1.0f / (1.0f + __expf(-x)); }
__device__ __forceinline__ float silu(float x) { return x / (1.0f + __expf(-x)); }
__device__ __forceinline__ float wave_sum(float v) {
#pragma unroll
    for (int o = 32; o >= 1; o >>= 1) v += __shfl_xor(v, o);
    return v;
}

struct EpiSwiglu {
    static constexpr bool PERM = true, AFTER_DRAIN = false;
    bf16_t* H;
    __device__ __forceinline__ void operator()(const f32x4 (&acc)[2][2][4][2], const Unit& u, int wr, int wc, int fr, int fq) const {
        const int row0 = u.pm * 256 + wr * 64 + fr, col0 = u.pn * 128 + wc * 32 + 8 * fq;
#pragma unroll
        for (int ai = 0; ai < 2; ++ai)
#pragma unroll
            for (int m = 0; m < 4; ++m) {
                bf16_t* rowp = H + (size_t)(row0 + ai * 128 + m * 16) * DFF + col0;
                f32x4 v0, v1;
#pragma unroll
                for (int j = 0; j < 4; ++j) { v0[j] = silu(acc[ai][0][m][0][j]) * acc[ai][1][m][0][j]; v1[j] = silu(acc[ai][0][m][1][j]) * acc[ai][1][m][1][j]; }
                u32x4 w; w.x = cvt_pk_bf16(v0[0], v0[1]); w.y = cvt_pk_bf16(v0[2], v0[3]); w.z = cvt_pk_bf16(v1[0], v1[1]); w.w = cvt_pk_bf16(v1[2], v1[3]);
                *(u32x4*)rowp = w;
            }
    }
};
struct EpiResid {
    static constexpr bool PERM = false, AFTER_DRAIN = false;
    float* X; float s;
    __device__ __forceinline__ void operator()(const f32x4 (&acc)[2][2][4][2], const Unit& u, int wr, int wc, int fr, int fq) const {
        const int row0 = u.pm * 256 + wr * 64 + fr, col0 = u.pn * 256 + wc * 32 + 4 * fq;
#pragma unroll
        for (int ai = 0; ai < 2; ++ai)
#pragma unroll
            for (int m = 0; m < 4; ++m) {
                float* rowp = X + (size_t)(row0 + ai * 128 + m * 16) * D + col0;
#pragma unroll
                for (int bj = 0; bj < 2; ++bj)
#pragma unroll
                    for (int n = 0; n < 2; ++n) { float* q = rowp + bj * 128 + n * 16; const f32x4 x = *(const f32x4*)q; *(f32x4*)q = x * ALPHA + acc[ai][bj][m][n] * s; }
            }
    }
};
struct EpiRoute {
    static constexpr bool PERM = true, AFTER_DRAIN = false;
    bf16_t* base; int ld; int tpb; size_t bstride; float* lr; int lr_tile;
    __device__ __forceinline__ void operator()(const f32x4 (&acc)[2][2][4][2], const Unit& u, int wr, int wc, int fr, int fq) const {
        const int row0 = u.pm * 256 + wr * 64 + fr;
        if (u.pn == lr_tile) {
            if (wc == 0) {
#pragma unroll
                for (int ai = 0; ai < 2; ++ai)
#pragma unroll
                    for (int m = 0; m < 4; ++m) {
                        float* rowp = lr + (size_t)(row0 + ai * 128 + m * 16) * 32 + 8 * fq;
                        *(f32x4*)rowp = acc[ai][0][m][0]; *(f32x4*)(rowp + 4) = acc[ai][0][m][1];
                    }
            }
            return;
        }
        const int b = tpb ? u.pn / tpb : 0; const int colt = (tpb ? (u.pn - b * tpb) : u.pn) * 256;
        bf16_t* dst = base + (size_t)b * bstride; const int col0 = colt + wc * 32 + 8 * fq;
#pragma unroll
        for (int ai = 0; ai < 2; ++ai)
#pragma unroll
            for (int m = 0; m < 4; ++m) {
                bf16_t* rowp = dst + (size_t)(row0 + ai * 128 + m * 16) * ld + col0;
#pragma unroll
                for (int bj = 0; bj < 2; ++bj) {
                    const f32x4 v0 = acc[ai][bj][m][0], v1 = acc[ai][bj][m][1];
                    u32x4 w; w.x = cvt_pk_bf16(v0[0], v0[1]); w.y = cvt_pk_bf16(v0[2], v0[3]); w.z = cvt_pk_bf16(v1[0], v1[1]); w.w = cvt_pk_bf16(v1[2], v1[3]);
                    *(u32x4*)(rowp + bj * 128) = w;
                }
            }
    }
};
struct EpiMerge {
    static constexpr bool PERM = true, AFTER_DRAIN = false;
    const bf16_t* YC; const bf16_t* YG; bf16_t* MG;
    __device__ __forceinline__ void operator()(const f32x4 (&acc)[2][2][4][2], const Unit& u, int wr, int wc, int fr, int fq) const {
        const int row0 = u.pm * 256 + wr * 64 + fr, col0 = u.pn * 128 + wc * 32 + 8 * fq;
#pragma unroll
        for (int ai = 0; ai < 2; ++ai)
#pragma unroll
            for (int m = 0; m < 4; ++m) {
                const size_t off = (size_t)(row0 + ai * 128 + m * 16) * D + col0;
                const u32x4 yc = *(const u32x4*)(YC + off), yg = *(const u32x4*)(YG + off);
                const f32x4 c0 = acc[ai][0][m][0], c1 = acc[ai][0][m][1], g0 = acc[ai][1][m][0], g1 = acc[ai][1][m][1];
                u32x4 w;
                w.x = cvt_pk_bf16(sigm(c0[0]) * bf_lo(yc.x) + sigm(g0[0]) * bf_lo(yg.x), sigm(c0[1]) * bf_hi(yc.x) + sigm(g0[1]) * bf_hi(yg.x));
                w.y = cvt_pk_bf16(sigm(c0[2]) * bf_lo(yc.y) + sigm(g0[2]) * bf_lo(yg.y), sigm(c0[3]) * bf_hi(yc.y) + sigm(g0[3]) * bf_hi(yg.y));
                w.z = cvt_pk_bf16(sigm(c1[0]) * bf_lo(yc.z) + sigm(g1[0]) * bf_lo(yg.z), sigm(c1[1]) * bf_hi(yc.z) + sigm(g1[1]) * bf_hi(yg.z));
                w.w = cvt_pk_bf16(sigm(c1[2]) * bf_lo(yc.w) + sigm(g1[2]) * bf_lo(yg.w), sigm(c1[3]) * bf_hi(yc.w) + sigm(g1[3]) * bf_hi(yg.w));
                *(u32x4*)(MG + off) = w;
            }
    }
};

template <class E>
__device__ __forceinline__ void run_gemm(PG8_LAS unsigned char* lds, const bf16_t* A, const bf16_t* Bt, int Mr, int N, int K, const E& e, int cshift) {
    pg8::Gemm g{A, Bt, Mr, N, K}; pg8::StaticOrder S; S.init(Mr, N, (int)gridDim.x, (int)((blockIdx.x + cshift) % gridDim.x));
    pg8::gemm_phase<E, pg8::StaticOrder, false>(lds, g, S, e, nullptr);
}

__device__ __forceinline__ int wmap(int mode, int n) {
    if (mode == 0) return n;
    if (mode == 1) { const int p = n >> 8, s = (n >> 7) & 1, j = n & 127; return s * DFF + 128 * p + j; }
    if (mode == 2) return n < 3104 ? n : -1;
    if (mode == 3) { const int p = n >> 8, s = (n >> 7) & 1, j = n & 127; return 3104 + s * 1024 + 128 * p + j; }
    return 1024 + n;
}
__device__ __forceinline__ void wprep_tile(PG8_LAS unsigned char* lds, const float* W, bf16_t* Wt, int K, int Nsrc, int mode, int tn, int tk) {
    ldsf T = (ldsf)lds;
    int tid = threadIdx.x; asm volatile("" : "+v"(tid));
    { const int tx = tid & 63, ty = tid >> 6; const int src = wmap(mode, tn * 64 + tx);
#pragma unroll
      for (int i = 0; i < 8; ++i) { const int kk = ty + i * 8; T[kk * 65 + tx] = src >= 0 ? W[(size_t)(tk * 64 + kk) * Nsrc + src] : 0.f; } }
    __syncthreads();
    { const int kx = tid & 31, ny = tid >> 5;
#pragma unroll
      for (int i = 0; i < 4; ++i) { const int nn = ny + i * 16; const unsigned w = cvt_pk_bf16(T[(2 * kx) * 65 + nn], T[(2 * kx + 1) * 65 + nn]);
          *(unsigned*)(Wt + (size_t)(tn * 64 + nn) * K + tk * 64 + 2 * kx) = w; } }
    __syncthreads();
}
__device__ __forceinline__ void phase_wprep(const Params& p, PG8_LAS unsigned char* lds, int l) {
    bf16_t* Wb = (bf16_t*)(p.ws + OFF_W);
    for (int t = blockIdx.x; t < 7104; t += gridDim.x) {
        const float* src; bf16_t* dst; int K, Nsrc, mode, base;
        if (t < 1408)      { src = p.in[4] + (size_t)l * 1024 * 5632;  dst = Wb + W_GU1; K = 1024; Nsrc = 5632; mode = 1; base = 0; }
        else if (t < 2112) { src = p.in[5] + (size_t)l * 2816 * 1024;  dst = Wb + W_D1;  K = 2816; Nsrc = 1024; mode = 0; base = 1408; }
        else if (t < 2944) { src = p.in[6] + (size_t)l * 1024 * 5152;  dst = Wb + W_INA; K = 1024; Nsrc = 5152; mode = 2; base = 2112; }
        else if (t < 3456) { src = p.in[6] + (size_t)l * 1024 * 5152;  dst = Wb + W_INM; K = 1024; Nsrc = 5152; mode = 3; base = 2944; }
        else if (t < 3584) { src = p.in[8] + (size_t)l * 512 * 1024;   dst = Wb + W_CO;  K = 512;  Nsrc = 1024; mode = 0; base = 3456; }
        else if (t < 3712) { src = p.in[12] + (size_t)l * 512 * 1024;  dst = Wb + W_GO;  K = 512;  Nsrc = 1024; mode = 0; base = 3584; }
        else if (t < 3968) { src = p.in[13] + (size_t)l * 1024 * 1024; dst = Wb + W_OUT; K = 1024; Nsrc = 1024; mode = 0; base = 3712; }
        else if (t < 4224) { src = p.in[14] + (size_t)l * 1024 * 1024; dst = Wb + W_Q;   K = 1024; Nsrc = 1024; mode = 0; base = 3968; }
        else if (t < 4480) { src = p.in[15] + (size_t)l * 1024 * 2048; dst = Wb + W_K;   K = 1024; Nsrc = 2048; mode = 0; base = 4224; }
        else if (t < 4736) { src = p.in[15] + (size_t)l * 1024 * 2048; dst = Wb + W_V;   K = 1024; Nsrc = 2048; mode = 4; base = 4480; }
        else if (t < 4992) { src = p.in[16] + (size_t)l * 1024 * 1024; dst = Wb + W_O;   K = 1024; Nsrc = 1024; mode = 0; base = 4736; }
        else if (t < 6400) { src = p.in[17] + (size_t)l * 1024 * 5632; dst = Wb + W_GU2; K = 1024; Nsrc = 5632; mode = 1; base = 4992; }
        else               { src = p.in[18] + (size_t)l * 2816 * 1024; dst = Wb + W_D2;  K = 2816; Nsrc = 1024; mode = 0; base = 6400; }
        const int ti = t - base, ntk = K >> 6;
        wprep_tile(lds, src, dst, K, Nsrc, mode, ti / ntk, ti % ntk);
    }
}
__device__ __forceinline__ void phase_prologue(const Params& p) {
    float* X = p.out; bf16_t* XB = (bf16_t*)(p.ws + OFF_XB); bf16_t* MEMB = (bf16_t*)(p.ws + OFF_MEMB);
    int tid = threadIdx.x; asm volatile("" : "+v"(tid)); const size_t nth = (size_t)gridDim.x * 512, t0 = (size_t)blockIdx.x * 512 + tid;
    const size_t n4 = (size_t)M * D / 4, np4 = (size_t)MP * D / 4;
    for (size_t i = t0; i < n4; i += nth) {
        const f32x4 v = i < np4 ? ((const f32x4*)p.in[0])[i] : ((const f32x4*)p.in[1])[i - np4];
        ((f32x4*)X)[i] = v; u32x2 w; w.x = cvt_pk_bf16(v[0], v[1]); w.y = cvt_pk_bf16(v[2], v[3]); ((u32x2*)XB)[i] = w;
    }
    const size_t m4 = (size_t)NMEM * D / 4, mp4 = (size_t)16 * 256 * D / 4;
    for (size_t i = t0; i < m4; i += nth) {
        const f32x4 v = i < mp4 ? ((const f32x4*)p.in[2])[i] : ((const f32x4*)p.in[3])[i - mp4];
        u32x2 w; w.x = cvt_pk_bf16(v[0], v[1]); w.y = cvt_pk_bf16(v[2], v[3]); ((u32x2*)MEMB)[i] = w;
    }
}
__device__ __forceinline__ void phase_ln(const Params& p, int l, int k) {
    float* X = p.out; bf16_t* XB = (bf16_t*)(p.ws + OFF_XB);
    const float* g = p.in[19] + (size_t)(l * 4 + k) * D; const float* b = p.in[20] + (size_t)(l * 4 + k) * D;
    int tid = threadIdx.x; asm volatile("" : "+v"(tid)); const int lane = tid & 63, wid = tid >> 6;
    f32x4 gv[4], bv[4];
#pragma unroll
    for (int i = 0; i < 4; ++i) { gv[i] = *(const f32x4*)(g + i * 256 + lane * 4); bv[i] = *(const f32x4*)(b + i * 256 + lane * 4); }
    for (int row = blockIdx.x * 8 + wid; row < M; row += gridDim.x * 8) {
        float* xr = X + (size_t)row * D; f32x4 v[4]; float s = 0.f;
#pragma unroll
        for (int i = 0; i < 4; ++i) { v[i] = *(const f32x4*)(xr + i * 256 + lane * 4); s += (v[i][0] + v[i][1]) + (v[i][2] + v[i][3]); }
        const float mean = wave_sum(s) * (1.0f / 1024.0f); float q = 0.f;
#pragma unroll
        for (int i = 0; i < 4; ++i) { const f32x4 d = v[i] - mean; q += (d[0] * d[0] + d[1] * d[1]) + (d[2] * d[2] + d[3] * d[3]); }
        const float rstd = rsqrtf(wave_sum(q) * (1.0f / 1024.0f) + 1e-5f);
#pragma unroll
        for (int i = 0; i < 4; ++i) { const f32x4 y = (v[i] - mean) * rstd * gv[i] + bv[i]; *(f32x4*)(xr + i * 256 + lane * 4) = y;
            u32x2 w; w.x = cvt_pk_bf16(y[0], y[1]); w.y = cvt_pk_bf16(y[2], y[3]); *(u32x2*)(XB + (size_t)row * D + i * 256 + lane * 4) = w; }
    }
}
__device__ __forceinline__ void phase_conv(const Params& p, int l, int worker, int nworkers) {
    const bf16_t* HC = (const bf16_t*)(p.ws + OFF_HC); bf16_t* GB = (bf16_t*)(p.ws + OFF_GB); const bf16_t* GC = (const bf16_t*)(p.ws + OFF_GC);
    const float* cw = p.in[7] + (size_t)l * 3 * 512;
    int tid = threadIdx.x; asm volatile("" : "+v"(tid));
    for (size_t i = (size_t)worker * 512 + tid; i < (size_t)M * 64; i += (size_t)nworkers * 512) {
        const int row = (int)(i >> 6), c8 = (int)(i & 63) * 8;
        int t, T; if (row < MP) { t = row & 2047; T = 2048; } else { t = (row - MP) & 4095; T = 4096; }
        const size_t o = (size_t)row * 512 + c8;
        const u32x4 z4 = {0u, 0u, 0u, 0u};
        const u32x4 h1 = *(const u32x4*)(HC + o), g1 = *(const u32x4*)(GC + o), gb = *(const u32x4*)(GB + o);
        const u32x4 h0 = t > 0 ? *(const u32x4*)(HC + o - 512) : z4, g0 = t > 0 ? *(const u32x4*)(GC + o - 512) : z4;
        const u32x4 h2 = t < T - 1 ? *(const u32x4*)(HC + o + 512) : z4, g2 = t < T - 1 ? *(const u32x4*)(GC + o + 512) : z4;
        const f32x4 w0a = *(const f32x4*)(cw + c8), w0b = *(const f32x4*)(cw + c8 + 4), w1a = *(const f32x4*)(cw + 512 + c8), w1b = *(const f32x4*)(cw + 512 + c8 + 4),
                    w2a = *(const f32x4*)(cw + 1024 + c8), w2b = *(const f32x4*)(cw + 1024 + c8 + 4);
        u32x4 r;
        float wv0[8] = {w0a[0], w0a[1], w0a[2], w0a[3], w0b[0], w0b[1], w0b[2], w0b[3]};
        float wv1[8] = {w1a[0], w1a[1], w1a[2], w1a[3], w1b[0], w1b[1], w1b[2], w1b[3]};
        float wv2[8] = {w2a[0], w2a[1], w2a[2], w2a[3], w2b[0], w2b[1], w2b[2], w2b[3]};
        const unsigned hw0[4] = {h0.x, h0.y, h0.z, h0.w}, gw0[4] = {g0.x, g0.y, g0.z, g0.w}, hw1[4] = {h1.x, h1.y, h1.z, h1.w}, gw1[4] = {g1.x, g1.y, g1.z, g1.w},
                       hw2[4] = {h2.x, h2.y, h2.z, h2.w}, gw2[4] = {g2.x, g2.y, g2.z, g2.w}, gbw[4] = {gb.x, gb.y, gb.z, gb.w};
        unsigned rw[4];
#pragma unroll
        for (int k = 0; k < 4; ++k) {
            const float lo = bf_lo(gbw[k]) * (wv0[2 * k] * (bf_lo(hw0[k]) * bf_lo(gw0[k])) + wv1[2 * k] * (bf_lo(hw1[k]) * bf_lo(gw1[k])) + wv2[2 * k] * (bf_lo(hw2[k]) * bf_lo(gw2[k])));
            const float hi = bf_hi(gbw[k]) * (wv0[2 * k + 1] * (bf_hi(hw0[k]) * bf_hi(gw0[k])) + wv1[2 * k + 1] * (bf_hi(hw1[k]) * bf_hi(gw1[k])) + wv2[2 * k + 1] * (bf_hi(hw2[k]) * bf_hi(gw2[k])));
            rw[k] = cvt_pk_bf16(lo, hi);
        }
        r.x = rw[0]; r.y = rw[1]; r.z = rw[2]; r.w = rw[3];
        *(u32x4*)(GB + o) = r;
    }
}

__device__ __forceinline__ void gla_load_block(const Params& p, PG8_LAS unsigned char* lds, int l, int h, int dir, int rowb) {
    ldsf sq = (ldsf)lds, sk = sq + 4096, sa = sk + 4096, sv = sa + 4096;
    const bf16_t* QK = (const bf16_t*)(p.ws + OFF_QK); const bf16_t* V = (const bf16_t*)(p.ws + OFF_V); const float* LR = (const float*)(p.ws + OFF_LR);
    int tid = threadIdx.x; asm volatile("" : "+v"(tid));
    { const int t = tid >> 3, d8 = (tid & 7) * 8; const size_t o = (size_t)(rowb + t) * 512 + h * 64 + d8;
      const u32x4 q = *(const u32x4*)(QK + o), k = *(const u32x4*)(QK + o + 256);
      const unsigned qw[4] = {q.x, q.y, q.z, q.w}, kw[4] = {k.x, k.y, k.z, k.w};
#pragma unroll
      for (int i = 0; i < 4; ++i) { sq[t * 64 + d8 + 2 * i] = bf_lo(qw[i]) * 0.125f; sq[t * 64 + d8 + 2 * i + 1] = bf_hi(qw[i]) * 0.125f; sk[t * 64 + d8 + 2 * i] = bf_lo(kw[i]); sk[t * 64 + d8 + 2 * i + 1] = bf_hi(kw[i]); } }
    { const int t = tid >> 3, e16 = (tid & 7) * 16; const size_t o = (size_t)(rowb + t) * 512 + h * 128 + e16;
#pragma unroll
      for (int hh = 0; hh < 2; ++hh) { const u32x4 v = *(const u32x4*)(V + o + hh * 8); const unsigned vw[4] = {v.x, v.y, v.z, v.w};
#pragma unroll
          for (int i = 0; i < 4; ++i) { sv[t * 128 + e16 + hh * 8 + 2 * i] = bf_lo(vw[i]); sv[t * 128 + e16 + hh * 8 + 2 * i + 1] = bf_hi(vw[i]); } } }
    { const int d = tid & 63, tg = tid >> 6;
      const float* w2 = p.in[9] + ((size_t)(l * 2 + dir) * 16) * 256 + h * 64 + d; const float bias = p.in[10][(size_t)(l * 2 + dir) * 256 + h * 64 + d];
      float w[16];
#pragma unroll
      for (int r = 0; r < 16; ++r) w[r] = w2[r * 256];
#pragma unroll
      for (int i = 0; i < 8; ++i) { const int t = tg * 8 + i; const float* lr = LR + (size_t)(rowb + t) * 32 + dir * 16; float z = bias;
#pragma unroll
          for (int r4 = 0; r4 < 4; ++r4) { const f32x4 x = *(const f32x4*)(lr + r4 * 4); z += x[0] * w[r4 * 4] + x[1] * w[r4 * 4 + 1] + x[2] * w[r4 * 4 + 2] + x[3] * w[r4 * 4 + 3]; }
          const float ls = fminf(z, 0.f) - log1pf(__expf(-fabsf(z)));
          sa[t * 64 + d] = __expf(ls * 0.0625f); } }
}
__device__ __forceinline__ void phase_gla_naive(const Params& p, PG8_LAS unsigned char* lds, int l, int item) {
    ldsf sq = (ldsf)lds, sk = sq + 4096, sa = sk + 4096, sv = sa + 4096, so = sv + 8192;
    float* OF = (float*)(p.ws + OFF_OF); const bf16_t* G = (const bf16_t*)(p.ws + OFF_G); bf16_t* AG = (bf16_t*)(p.ws + OFF_AGLA);
    const int seq = item >> 2, h = item & 3;
    const int row0 = seq < 16 ? seq * 2048 : MP + (seq - 16) * 4096, T = seq < 16 ? 2048 : 4096, nb = T >> 6;
    int tid = threadIdx.x; asm volatile("" : "+v"(tid)); const int e = tid >> 2, dg = tid & 3, lane = tid & 63, wid = tid >> 6;
    float S[16];
#pragma unroll
    for (int i = 0; i < 16; ++i) S[i] = 0.f;
    for (int blk = 0; blk < nb; ++blk) {
        const int rowb = row0 + blk * 64;
        gla_load_block(p, lds, l, h, 0, rowb);
        __syncthreads();
        for (int t = 0; t < 64; ++t) {
            const float vv = sv[t * 128 + e]; float po = 0.f;
#pragma unroll
            for (int i4 = 0; i4 < 4; ++i4) {
                const f32x4 a = *(const PG8_LAS f32x4*)(sa + t * 64 + dg * 16 + i4 * 4), k = *(const PG8_LAS f32x4*)(sk + t * 64 + dg * 16 + i4 * 4), q = *(const PG8_LAS f32x4*)(sq + t * 64 + dg * 16 + i4 * 4);
#pragma unroll
                for (int j = 0; j < 4; ++j) { S[i4 * 4 + j] = a[j] * S[i4 * 4 + j] + k[j] * vv; po += q[j] * S[i4 * 4 + j]; }
            }
            po += __shfl_xor(po, 1); po += __shfl_xor(po, 2);
            if (dg == 0) so[t * 128 + e] = po;
        }
        __syncthreads();
#pragma unroll
        for (int i = 0; i < 16; ++i) { const int idx = i * 512 + tid; const int t = idx >> 7, ee = idx & 127; OF[(size_t)(rowb + t) * 512 + h * 128 + ee] = so[idx]; }
        __syncthreads();
    }
#pragma unroll
    for (int i = 0; i < 16; ++i) S[i] = 0.f;
    const float ng0 = p.in[11][(size_t)l * 128 + lane], ng1 = p.in[11][(size_t)l * 128 + 64 + lane];
    for (int blk = nb - 1; blk >= 0; --blk) {
        const int rowb = row0 + blk * 64;
        gla_load_block(p, lds, l, h, 1, rowb);
        __syncthreads();
        for (int t = 63; t >= 0; --t) {
            const float vv = sv[t * 128 + e]; float po = 0.f;
#pragma unroll
            for (int i4 = 0; i4 < 4; ++i4) {
                const f32x4 a = *(const PG8_LAS f32x4*)(sa + t * 64 + dg * 16 + i4 * 4), k = *(const PG8_LAS f32x4*)(sk + t * 64 + dg * 16 + i4 * 4), q = *(const PG8_LAS f32x4*)(sq + t * 64 + dg * 16 + i4 * 4);
#pragma unroll
                for (int j = 0; j < 4; ++j) { const float sd = a[j] * S[i4 * 4 + j]; po += q[j] * sd; S[i4 * 4 + j] = sd + k[j] * vv; }
            }
            po += __shfl_xor(po, 1); po += __shfl_xor(po, 2);
            if (dg == 0) so[t * 128 + e] = po;
        }
        __syncthreads();
#pragma unroll
        for (int i = 0; i < 8; ++i) {
            const int t = wid * 8 + i; const size_t ro = (size_t)(rowb + t) * 512 + h * 128;
            const float o0 = so[t * 128 + lane] + OF[ro + lane], o1 = so[t * 128 + 64 + lane] + OF[ro + 64 + lane];
            const float ss = wave_sum(o0 * o0 + o1 * o1); const float rstd = rsqrtf(ss * (1.0f / 128.0f) + 1e-6f);
            const float g0 = bf2f(G[ro + lane]), g1 = bf2f(G[ro + 64 + lane]);
            const float y0 = o0 * rstd * ng0 * silu(g0), y1 = o1 * rstd * ng1 * silu(g1);
            AG[ro + lane] = (bf16_t)(cvt_pk_bf16(y0, 0.f) & 0xffffu); AG[ro + 64 + lane] = (bf16_t)(cvt_pk_bf16(y1, 0.f) & 0xffffu);
        }
        __syncthreads();
    }
}

__device__ __forceinline__ void phase_xa(const Params& p) {
    const bf16_t* Q = (const bf16_t*)(p.ws + OFF_QK); const bf16_t* KM = (const bf16_t*)(p.ws + OFF_KM); const bf16_t* VT = (const bf16_t*)(p.ws + OFF_VT);
    bf16_t* AO = (bf16_t*)(p.ws + OFF_OF);
    int tid = threadIdx.x; asm volatile("" : "+v"(tid)); const int lane = tid & 63, wid = tid >> 6, fr = lane & 15, fq = lane >> 4;
    for (int item = blockIdx.x; item < 768; item += gridDim.x) {
        const int pm = item >> 2, h = item & 3;
        const int r0 = pm * 256 + wid * 32;
        const int b = r0 < MP ? (r0 >> 11) : 16 + ((r0 - MP) >> 12);
        const int mb = b * 256;
        f32x4 acc[16][2];
#pragma unroll
        for (int kb = 0; kb < 16; ++kb) { acc[kb][0] = (f32x4){0.f, 0.f, 0.f, 0.f}; acc[kb][1] = (f32x4){0.f, 0.f, 0.f, 0.f}; }
        const bf16_t* qp = Q + (size_t)(r0 + fr) * D + h * 256 + fq * 8;
        const bf16_t* kp = KM + (size_t)(mb + fr) * D + h * 256 + fq * 8;
#pragma unroll 1
        for (int ks = 0; ks < 8; ++ks) {
            const bf16x8 q0 = *(const bf16x8*)(qp + ks * 32), q1 = *(const bf16x8*)(qp + 16 * D + ks * 32);
#pragma unroll
            for (int kg = 0; kg < 4; ++kg) {
                bf16x8 kf[4];
#pragma unroll
                for (int k4 = 0; k4 < 4; ++k4) kf[k4] = *(const bf16x8*)(kp + (size_t)(kg * 4 + k4) * 16 * D + ks * 32);
#pragma unroll
                for (int k4 = 0; k4 < 4; ++k4) {
                    acc[kg * 4 + k4][0] = __builtin_amdgcn_mfma_f32_16x16x32_bf16(kf[k4], q0, acc[kg * 4 + k4][0], 0, 0, 0);
                    acc[kg * 4 + k4][1] = __builtin_amdgcn_mfma_f32_16x16x32_bf16(kf[k4], q1, acc[kg * 4 + k4][1], 0, 0, 0);
                }
                asm volatile("" ::: "memory");
            }
        }
        float inv[2]; bf16x8 pf[8][2];
#pragma unroll
        for (int rb = 0; rb < 2; ++rb) {
            float mx = -3.0e38f;
#pragma unroll
            for (int kb = 0; kb < 16; ++kb)
#pragma unroll
                for (int j = 0; j < 4; ++j) mx = fmaxf(mx, acc[kb][rb][j]);
            mx = fmaxf(mx, __shfl_xor(mx, 16)); mx = fmaxf(mx, __shfl_xor(mx, 32));
            float sum = 0.f;
            const float c = 0.0625f * 1.44269504088896f;
#pragma unroll
            for (int kb = 0; kb < 16; ++kb)
#pragma unroll
                for (int j = 0; j < 4; ++j) { const float e = exp2f((acc[kb][rb][j] - mx) * c); acc[kb][rb][j] = e; sum += e; }
            sum += __shfl_xor(sum, 16); sum += __shfl_xor(sum, 32);
            inv[rb] = 1.0f / sum;
#pragma unroll
            for (int s = 0; s < 8; ++s) {
                typedef unsigned u4v __attribute__((ext_vector_type(4)));
                u4v w; w.x = cvt_pk_bf16(acc[2 * s][rb][0], acc[2 * s][rb][1]); w.y = cvt_pk_bf16(acc[2 * s][rb][2], acc[2 * s][rb][3]);
                w.z = cvt_pk_bf16(acc[2 * s + 1][rb][0], acc[2 * s + 1][rb][1]); w.w = cvt_pk_bf16(acc[2 * s + 1][rb][2], acc[2 * s + 1][rb][3]);
                pf[s][rb] = __builtin_bit_cast(bf16x8, w);
            }
        }
        const bf16_t* vp = VT + (size_t)(h * 256 + fr) * NMEM + mb + fq * 4;
#pragma unroll 1
        for (int db = 0; db < 16; ++db) {
            f32x4 o0 = (f32x4){0.f, 0.f, 0.f, 0.f}, o1 = (f32x4){0.f, 0.f, 0.f, 0.f};
#pragma unroll
            for (int s = 0; s < 8; ++s) {
                const u32x2 a = *(const u32x2*)(vp + (size_t)db * 16 * NMEM + s * 32), c = *(const u32x2*)(vp + (size_t)db * 16 * NMEM + s * 32 + 16);
                typedef unsigned u4v __attribute__((ext_vector_type(4)));
                u4v w; w.x = a.x; w.y = a.y; w.z = c.x; w.w = c.y;
                const bf16x8 vf = __builtin_bit_cast(bf16x8, w);
                o0 = __builtin_amdgcn_mfma_f32_16x16x32_bf16(vf, pf[s][0], o0, 0, 0, 0);
                o1 = __builtin_amdgcn_mfma_f32_16x16x32_bf16(vf, pf[s][1], o1, 0, 0, 0);
            }
            u32x2 w0, w1; w0.x = cvt_pk_bf16(o0[0] * inv[0], o0[1] * inv[0]); w0.y = cvt_pk_bf16(o0[2] * inv[0], o0[3] * inv[0]);
            w1.x = cvt_pk_bf16(o1[0] * inv[1], o1[1] * inv[1]); w1.y = cvt_pk_bf16(o1[2] * inv[1], o1[3] * inv[1]);
            *(u32x2*)(AO + (size_t)(r0 + fr) * D + h * 256 + db * 16 + fq * 4) = w0;
            *(u32x2*)(AO + (size_t)(r0 + 16 + fr) * D + h * 256 + db * 16 + fq * 4) = w1;
        }
    }
}

__global__ void __launch_bounds__(512, 2) mega(Params p) {
    extern __shared__ __attribute__((aligned(16))) unsigned char lds_raw[];
    PG8_LAS unsigned char* lds = (PG8_LAS unsigned char*)lds_raw;
    unsigned char* ws = p.ws;
    bf16_t* Wb = (bf16_t*)(ws + OFF_W); bf16_t* XB = (bf16_t*)(ws + OFF_XB); bf16_t* HB = (bf16_t*)(ws + OFF_HC);
    for (int ph = p.ph_lo; ph < p.ph_hi; ++ph) {
        const int l = ph / NPH, s = ph % NPH;
#ifdef ONLY_S
        if (!(ONLY_S)) continue;
#endif
        if (s == 0) {
            if (l == 0) phase_prologue(p);
            phase_wprep(p, lds, l);
        } else if (s == 1 || s == 14) {
            EpiSwiglu e{HB};
            run_gemm<EpiSwiglu>(lds, XB, Wb + (s == 1 ? W_GU1 : W_GU2), M, 5632, 1024, e, 0);
        } else if (s == 2 || s == 8 || s == 12 || s == 15) {
            const bf16_t* A; const bf16_t* Bt; int K; float sc;
            if (s == 2)       { A = HB; Bt = Wb + W_D1; K = DFF; sc = 0.5f; }
            else if (s == 8)  { A = (const bf16_t*)(ws + OFF_HC); Bt = Wb + W_OUT; K = 1024; sc = 1.0f; }
            else if (s == 12) { A = (const bf16_t*)(ws + OFF_OF); Bt = Wb + W_O; K = 1024; sc = 1.0f; }
            else              { A = HB; Bt = Wb + W_D2; K = DFF; sc = 0.5f; }
            EpiResid e{p.out, sc};
            run_gemm<EpiResid>(lds, A, Bt, M, 1024, K, e, 0);
        } else if (s == 3 || s == 9 || s == 13 || s == 16) {
            phase_ln(p, l, s == 3 ? 0 : (s == 9 ? 1 : (s == 13 ? 2 : 3)));
        } else if (s == 4 || s == 6 || s == 10) {
            const int ng = s == 4 ? 1 : (s == 6 ? 2 : 3);
            for (int gi = 0; gi < ng; ++gi) {
                const bf16_t* A; const bf16_t* Bt; int Mr, N, K, cs = 0; EpiRoute e{nullptr, 0, 0, 0, nullptr, -1};
                if (s == 4) { A = XB; Bt = Wb + W_INA; Mr = M; N = 3328; K = 1024; e.base = (bf16_t*)(ws + OFF_HC); e.ld = 512; e.tpb = 2; e.bstride = (size_t)M * 512; e.lr = (float*)(ws + OFF_LR); e.lr_tile = 12; }
                else if (s == 6) {
                    if (gi == 0) { A = (const bf16_t*)(ws + OFF_GB); Bt = Wb + W_CO; e.base = (bf16_t*)(ws + OFF_QK); }
                    else         { A = (const bf16_t*)(ws + OFF_AGLA); Bt = Wb + W_GO; e.base = (bf16_t*)(ws + OFF_OF); }
                    Mr = M; N = 1024; K = 512; e.ld = 1024;
                } else {
                    if (gi == 0)      { A = XB; Bt = Wb + W_Q; Mr = M; N = 1024; e.base = (bf16_t*)(ws + OFF_QK); e.ld = 1024; }
                    else if (gi == 1) { A = (const bf16_t*)(ws + OFF_MEMB); Bt = Wb + W_K; Mr = NMEM; N = 1024; e.base = (bf16_t*)(ws + OFF_KM); e.ld = 1024; }
                    else              { A = Wb + W_V; Bt = (const bf16_t*)(ws + OFF_MEMB); Mr = 1024; N = NMEM; e.base = (bf16_t*)(ws + OFF_VT); e.ld = NMEM; cs = (int)gridDim.x - 80; }
                    K = 1024;
                }
                run_gemm<EpiRoute>(lds, A, Bt, Mr, N, K, e, cs);
            }
        } else if (s == 5) {
            if (gridDim.x > 160) {
                if (blockIdx.x < 80) phase_gla_naive(p, lds, l, (int)blockIdx.x);
                else phase_conv(p, l, (int)blockIdx.x - 80, (int)gridDim.x - 80);
            } else {
                phase_conv(p, l, (int)blockIdx.x, (int)gridDim.x);
                for (int it = blockIdx.x; it < 80; it += gridDim.x) phase_gla_naive(p, lds, l, it);
            }
        } else if (s == 7) {
            EpiMerge e{(const bf16_t*)(ws + OFF_QK), (const bf16_t*)(ws + OFF_OF), (bf16_t*)(ws + OFF_HC)};
            run_gemm<EpiMerge>(lds, XB, Wb + W_INM, M, 2048, 1024, e, 0);
        } else if (s == 11) {
            phase_xa(p);
        }
        if (ph + 1 < p.ph_hi) { if (p.coop) cg::this_grid().sync(); }
    }
}
}

extern "C" void kernel_launch(void* const* d_in, const int* in_sizes, int n_in, void* d_out, int out_size, void* d_ws, size_t ws_size, hipStream_t stream) {
    static int grid = 0;
    if (grid == 0) {
        if (n_in != 21 || ws_size < mk::WS_END) { fprintf(stderr, "kernel_launch: unexpected n_in %d / ws %zu (need %zu)\n", n_in, ws_size, (size_t)mk::WS_END); grid = -1; return; }
        int dev = 0, cus = 0, per_cu = 0;
        hipGetDevice(&dev); hipDeviceGetAttribute(&cus, hipDeviceAttributeMultiprocessorCount, dev);
        if (hipFuncSetAttribute((const void*)mk::mega, hipFuncAttributeMaxDynamicSharedMemorySize, mk::LDS_BYTES) != hipSuccess) { fprintf(stderr, "hipFuncSetAttribute failed\n"); grid = -1; return; }
        if (hipOccupancyMaxActiveBlocksPerMultiprocessor(&per_cu, (const void*)mk::mega, 512, mk::LDS_BYTES) != hipSuccess || per_cu < 1) { fprintf(stderr, "occupancy query: %d\n", per_cu); per_cu = 1; }
        (void)hipGetLastError();
        grid = cus * per_cu;
    }
    if (grid < 0) return;
    mk::Params p{};
    for (int i = 0; i < 21; ++i) p.in[i] = (const float*)d_in[i];
    p.out = (float*)d_out; p.ws = (unsigned char*)d_ws; p.ph_lo = 0; p.ph_hi = mk::NL * mk::NPH; p.coop = 1; p.pad = 0;
    void* args[] = {&p};
    hipError_t e = hipLaunchCooperativeKernel((const void*)mk::mega, dim3(grid), dim3(512), args, mk::LDS_BYTES, stream);
    if (e != hipSuccess) fprintf(stderr, "cooperative launch failed: %s (grid %d)\n", hipGetErrorString(e), grid);
}
```

```cpp
#include <hip/hip_runtime.h>
#include <hip/hip_cooperative_groups.h>
#include <cstdio>
namespace cg = cooperative_groups;
#ifndef NAIVE_GLA
#define NAIVE_GLA 0
#endif
namespace pg8 {
#define PG8_LAS __attribute__((address_space(3)))
typedef unsigned short bf16_t;
typedef short bf16x8 __attribute__((ext_vector_type(8)));
typedef float f32x4 __attribute__((ext_vector_type(4)));
typedef unsigned u32x4 __attribute__((ext_vector_type(4)));
constexpr int BM = 256, BK = 64, HALF = 128, HTB = HALF * BK * 2  , STAGE_BYTES = 8 * HTB, NXCD = 8, WGM = 8;

__host__ __device__ __forceinline__ int lds_byte(int r, int c) { const int st = (r >> 4) * 2 + (c >> 5), rr = r & 15, cc = c & 31, ob = rr * 64 + cc * 2; return st * 1024 + (ob ^ (((ob >> 9) & 1) << 5)); }
__host__ __device__ __forceinline__ void stage_rc(int b, int& R, int& C) { const int st = b / 1024, sb = b % 1024, swz = sb ^ (((sb >> 9) & 1) << 5); R = (st >> 1) * 16 + swz / 64; C = (st & 1) * 32 + (swz % 64) / 2; }
__host__ __device__ __forceinline__ int perm32(int rho) { const int n = rho >> 4, i = rho & 15; return 8 * (i >> 2) + 4 * n + (i & 3); }

struct Unit { int pm, pn; };
struct Gemm { const bf16_t* A; const bf16_t* Bt; int M, N, K; };

struct StaticOrder {
    int nM, nN, nwg, G, c;
    __host__ __device__ void init(int M, int N, int G_, int c_) { nM = M / BM; nN = N / BM; nwg = nM * nN; G = G_; c = c_; }
    __host__ __device__ bool next(int i, Unit& u) const {
        const long L = (long)i * G + c; if (L >= nwg) return false;
        int wgid = (int)L; { const int q = nwg / NXCD, r = nwg % NXCD, xcd = wgid % NXCD, off = wgid / NXCD; wgid = (xcd < r ? xcd * (q + 1) : r * (q + 1) + (xcd - r) * q) + off; }
        const int nig = WGM * nN, gid = wgid / nig, fm = gid * WGM, gsz = (nM - fm) < WGM ? (nM - fm) : WGM;
        u.pm = fm + ((wgid % nig) % gsz); u.pn = (wgid % nig) / gsz; return true;
    }
    __device__ __forceinline__ void a_ready(const Unit&) const {}
    __device__ __forceinline__ void done(const Unit&) const {}
};
struct CountedOrder : StaticOrder {
    const unsigned* ready; unsigned need; unsigned* tmo;
    __device__ __forceinline__ void a_ready(const Unit& u) const {
        if (threadIdx.x < 64) {
            const unsigned long long t0 = __builtin_amdgcn_s_memrealtime(); unsigned polls = 0;
            while ((unsigned)__builtin_amdgcn_readfirstlane(__hip_atomic_load(ready + 64 * u.pm, __ATOMIC_RELAXED, __HIP_MEMORY_SCOPE_AGENT)) < need) {
                if ((++polls & 255u) == 0u && __builtin_amdgcn_readfirstlane(__hip_atomic_load(tmo, __ATOMIC_RELAXED, __HIP_MEMORY_SCOPE_AGENT)) != 0u) break;
                if (__builtin_amdgcn_s_memrealtime() - t0 > 2000000ull) {
                    if (threadIdx.x == 0) { unsigned expect = 0u; __hip_atomic_compare_exchange_strong(tmo + 1, &expect, 0x600u | (unsigned)(u.pm & 0xff), __ATOMIC_RELAXED, __ATOMIC_RELAXED, __HIP_MEMORY_SCOPE_AGENT); __hip_atomic_store(tmo, 1u, __ATOMIC_RELAXED, __HIP_MEMORY_SCOPE_AGENT); }
                    break; }
                __builtin_amdgcn_s_sleep(2); }
            __builtin_amdgcn_fence(__ATOMIC_ACQUIRE, "agent");
            asm volatile("s_waitcnt vmcnt(0)" ::: "memory");
        }
#if !defined(BROKEN_HOOK_NO_BARRIER)
        asm volatile("" ::: "memory"); __builtin_amdgcn_s_barrier(); asm volatile("" ::: "memory");
#endif
    }
};

__device__ __forceinline__ unsigned cvt_pk_bf16(float lo, float hi) { typedef __bf16 bf2_ __attribute__((ext_vector_type(2))); typedef float f2_ __attribute__((ext_vector_type(2))); const f2_ v = {lo, hi}; return __builtin_bit_cast(unsigned, __builtin_convertvector(v, bf2_)); }
typedef float f32x2 __attribute__((ext_vector_type(2)));
__device__ __forceinline__ f32x2 gelu_pk(f32x2 v) {
    const f32x2 av = __builtin_elementwise_abs(v), d = av * 0.2316418882f + 1.0f;
    f32x2 t; t.x = __builtin_amdgcn_rcpf(d.x); t.y = __builtin_amdgcn_rcpf(d.y);
    f32x2 q = t * 0.5307027145f + (-0.7265760135f); q = q * t + 0.7107068705f; q = q * t + (-0.142248368f); q = q * t + 0.127414796f; q = q * t;
    const f32x2 s = (v * v) * (-0.72134752044f);
    f32x2 e; e.x = __builtin_amdgcn_exp2f(s.x); e.y = __builtin_amdgcn_exp2f(s.y);
    const f32x2 m = v * (q * e), r = v - m;
    f32x2 o; o.x = v.x < 0.f ? m.x : r.x; o.y = v.y < 0.f ? m.y : r.y; return o;
}

struct EpiF32 {
    static constexpr bool PERM = false, AFTER_DRAIN = false;
    float* C; int ldc; const float* bias;
    __device__ __forceinline__ void operator()(const f32x4 (&acc)[2][2][4][2], const Unit& u, int wr, int wc, int fr, int fq) const {
        const int row0 = u.pm * BM + wr * 64 + fr, col0 = u.pn * BM + wc * 32 + 4 * fq;
        f32x4 bv[2][2];
#pragma unroll
        for (int bj = 0; bj < 2; ++bj)
#pragma unroll
            for (int n = 0; n < 2; ++n) bv[bj][n] = bias ? *(const f32x4*)(bias + col0 + bj * HALF + n * 16) : (f32x4){0.f, 0.f, 0.f, 0.f};
#pragma unroll
        for (int ai = 0; ai < 2; ++ai)
#pragma unroll
            for (int m = 0; m < 4; ++m) { float* rowp = C + (size_t)(row0 + ai * HALF + m * 16) * ldc + col0;
#pragma unroll
                for (int bj = 0; bj < 2; ++bj)
#pragma unroll
                    for (int n = 0; n < 2; ++n) *(f32x4*)(rowp + bj * HALF + n * 16) = acc[ai][bj][m][n] + bv[bj][n]; }
    }
};
template <int ACT  > struct EpiBf16 {
    static constexpr bool PERM = true, AFTER_DRAIN = false;
    bf16_t* O; int ldc; const float* bias; int split_cols; size_t split_stride;
    __device__ __forceinline__ void operator()(const f32x4 (&acc)[2][2][4][2], const Unit& u, int wr, int wc, int fr, int fq) const {
        const int row0 = u.pm * BM + wr * 64 + fr; int colt = u.pn * BM; bf16_t* base = O;
        if (split_cols) { const int t = colt / split_cols; base += (size_t)t * split_stride; colt -= t * split_cols; }
        const int col0 = colt + wc * 32 + 8 * fq, bcol0 = u.pn * BM + wc * 32 + 8 * fq;
        f32x4 bv[2][2];
#pragma unroll
        for (int bj = 0; bj < 2; ++bj)
#pragma unroll
            for (int n = 0; n < 2; ++n) bv[bj][n] = bias ? *(const f32x4*)(bias + bcol0 + bj * HALF + 4 * n) : (f32x4){0.f, 0.f, 0.f, 0.f};
#pragma unroll
        for (int ai = 0; ai < 2; ++ai)
#pragma unroll
            for (int m = 0; m < 4; ++m) { bf16_t* rowp = base + (size_t)(row0 + ai * HALF + m * 16) * ldc + col0;
#pragma unroll
                for (int bj = 0; bj < 2; ++bj) { f32x4 v0 = acc[ai][bj][m][0] + bv[bj][0], v1 = acc[ai][bj][m][1] + bv[bj][1];
                    if (ACT == 1) { f32x2 a = gelu_pk((f32x2){v0[0], v0[1]}), b = gelu_pk((f32x2){v0[2], v0[3]}), c = gelu_pk((f32x2){v1[0], v1[1]}), d = gelu_pk((f32x2){v1[2], v1[3]});
                        v0 = (f32x4){a.x, a.y, b.x, b.y}; v1 = (f32x4){c.x, c.y, d.x, d.y}; }
                    if (ACT == 2) {
#pragma unroll
                        for (int j = 0; j < 4; ++j) { v0[j] = 0.5f * v0[j] * (1.0f + erff(v0[j] * 0.70710678f)); v1[j] = 0.5f * v1[j] * (1.0f + erff(v1[j] * 0.70710678f)); } }
                    u32x4 w; w.x = cvt_pk_bf16(v0[0], v0[1]); w.y = cvt_pk_bf16(v0[2], v0[3]); w.z = cvt_pk_bf16(v1[0], v1[1]); w.w = cvt_pk_bf16(v1[2], v1[3]);
                    *(u32x4*)(rowp + bj * HALF) = w; } }
    }
};

struct PanelStats {
    unsigned* xbuf;
    unsigned* cnt;
    unsigned* tmo;
    int ntn; float eps;
    unsigned code;
    __device__ __forceinline__ bool run(const f32x4 (&v)[2][2][4][2], const Unit& u, int wr, int wc, int fr, int fq, PG8_LAS unsigned char* lds, int wid, int lane) const {
        typedef float f32x2v __attribute__((ext_vector_type(2)));
        PG8_LAS f32x2v* P = (PG8_LAS f32x2v*)lds;
        PG8_LAS f32x2v* S = (PG8_LAS f32x2v*)(lds + 8192);
        PG8_LAS unsigned* flag = (PG8_LAS unsigned*)(lds + 8192 + 2048);
#pragma unroll
        for (int ai = 0; ai < 2; ++ai)
#pragma unroll
            for (int m = 0; m < 4; ++m) {
                float s = 0.f;
#pragma unroll
                for (int bj = 0; bj < 2; ++bj)
#pragma unroll
                    for (int n = 0; n < 2; ++n) { const f32x4 x = v[ai][bj][m][n]; s += (x[0] + x[1]) + (x[2] + x[3]); }
                s += __shfl_xor(s, 16); s += __shfl_xor(s, 32);
                const float mw = s * (1.0f / 64.0f); float q = 0.f;
#pragma unroll
                for (int bj = 0; bj < 2; ++bj)
#pragma unroll
                    for (int n = 0; n < 2; ++n) { const f32x4 d = v[ai][bj][m][n] - mw; q += (d[0] * d[0] + d[1] * d[1]) + (d[2] * d[2] + d[3] * d[3]); }
                q += __shfl_xor(q, 16); q += __shfl_xor(q, 32);
                if (fq == 0) P[(ai * HALF + wr * 64 + m * 16 + fr) * 4 + wc] = (f32x2v){mw, q};
            }
        asm volatile("s_waitcnt lgkmcnt(0)" ::: "memory"); __builtin_amdgcn_s_barrier(); asm volatile("" ::: "memory");
#if defined(BROKEN_NO_WAIT)
        if (blockIdx.x >= 64) { const long long t0 = clock64(); while (clock64() - t0 < 60000) __builtin_amdgcn_s_sleep(8); }
#endif
        const int row = wid * 32 + (lane & 31);
        if (lane < 32) {
            const f32x2v a = P[row * 4 + 0], b = P[row * 4 + 1], c = P[row * 4 + 2], d = P[row * 4 + 3];
            const float mt = (a.x + b.x + c.x + d.x) * 0.25f;
            const float da = a.x - mt, db = b.x - mt, dc = c.x - mt, dd = d.x - mt;
            const float m2 = (a.y + b.y) + (c.y + d.y) + 64.0f * ((da * da + db * db) + (dc * dc + dd * dd));
            unsigned long long* slot = (unsigned long long*)xbuf + ((size_t)(u.pm * BM + row) * 4 + u.pn);
            __hip_atomic_store(slot, ((unsigned long long)__float_as_uint(m2) << 32) | __float_as_uint(mt), __ATOMIC_RELAXED, __HIP_MEMORY_SCOPE_AGENT);
        }
        asm volatile("s_waitcnt vmcnt(0)" ::: "memory");
        if (lane == 0) __hip_atomic_fetch_add(cnt + 64 * u.pm, 1u, __ATOMIC_RELAXED, __HIP_MEMORY_SCOPE_AGENT);
        if (wid == 0) {
            bool dead = false; const unsigned long long t0 = __builtin_amdgcn_s_memrealtime(); const unsigned want = 8u * (unsigned)ntn;
            for (;;) {
#if defined(BROKEN_NO_WAIT)
                break;
#endif
                if ((unsigned)__builtin_amdgcn_readfirstlane(__hip_atomic_load(cnt + 64 * u.pm, __ATOMIC_RELAXED, __HIP_MEMORY_SCOPE_AGENT)) >= want) break;
                if (__builtin_amdgcn_s_memrealtime() - t0 > 2000000ull) {
                    if (lane == 0) { unsigned expect = 0u; __hip_atomic_compare_exchange_strong(tmo + 1, &expect, code | (unsigned)(u.pm & 0xff), __ATOMIC_RELAXED, __ATOMIC_RELAXED, __HIP_MEMORY_SCOPE_AGENT);
                                     __hip_atomic_store(tmo, 1u, __ATOMIC_RELAXED, __HIP_MEMORY_SCOPE_AGENT); }
                    dead = true; break; }
                __builtin_amdgcn_s_sleep(2);
            }
            __builtin_amdgcn_fence(__ATOMIC_ACQUIRE, "agent");
            if (lane == 0) flag[0] = dead ? 1u : 0u;
        }
        asm volatile("s_waitcnt vmcnt(0) lgkmcnt(0)" ::: "memory"); __builtin_amdgcn_s_barrier(); asm volatile("" ::: "memory");
        const bool bad = flag[0] != 0u;
        if (lane < 32) {
            const unsigned long long* slot = (const unsigned long long*)xbuf + (size_t)(u.pm * BM + row) * 4; float mt[4], m2[4]; float ms = 0.f;
#pragma unroll
            for (int t = 0; t < 4; ++t) { if (t < ntn) { const unsigned long long w = __hip_atomic_load(slot + t, __ATOMIC_RELAXED, __HIP_MEMORY_SCOPE_AGENT); mt[t] = __uint_as_float((unsigned)w); m2[t] = __uint_as_float((unsigned)(w >> 32)); } else { mt[t] = 0.f; m2[t] = 0.f; } ms += mt[t]; }
            const float mean = ms / (float)ntn; float q = 0.f;
#pragma unroll
            for (int t = 0; t < 4; ++t) if (t < ntn) { const float dm = mt[t] - mean; q += m2[t] + 256.0f * dm * dm; }
            S[row] = (f32x2v){mean, 1.0f / sqrtf(q / (256.0f * (float)ntn) + eps)};
        }
        asm volatile("s_waitcnt lgkmcnt(0)" ::: "memory"); __builtin_amdgcn_s_barrier(); asm volatile("" ::: "memory");
        return bad;
    }
};
struct EpiLnRes {
    static constexpr bool PERM = false, AFTER_DRAIN = true;
    const float* base; float* out; int ldc; const float* bias; PanelStats st; unsigned poison;
    __device__ __forceinline__ void refuse(size_t i0, size_t stride, int M, int N) const { const float q = __builtin_nanf(""); for (size_t i = i0; i < (size_t)M * N; i += stride) out[(i / N) * ldc + i % N] = q;
        if (i0 == 0) { unsigned expect = 0u; __hip_atomic_compare_exchange_strong(st.tmo + 1, &expect, 0x7f0u, __ATOMIC_RELAXED, __ATOMIC_RELAXED, __HIP_MEMORY_SCOPE_AGENT); __hip_atomic_store(st.tmo, 1u, __ATOMIC_RELAXED, __HIP_MEMORY_SCOPE_AGENT); } }
    __device__ __forceinline__ void fused(f32x4 (&acc)[2][2][4][2], const Unit& u, int wr, int wc, int fr, int fq, PG8_LAS unsigned char* lds, int wid, int lane) const {
        typedef float f32x2v __attribute__((ext_vector_type(2)));
        const PG8_LAS f32x2v* S = (const PG8_LAS f32x2v*)(lds + 8192);
        const int col0 = u.pn * BM + wc * 32 + 4 * fq;
#pragma unroll
        for (int bj = 0; bj < 2; ++bj)
#pragma unroll
            for (int n = 0; n < 2; ++n) { const f32x4 bv = bias ? *(const f32x4*)(bias + col0 + bj * HALF + n * 16) : (f32x4){0.f, 0.f, 0.f, 0.f};
#pragma unroll
                for (int ai = 0; ai < 2; ++ai)
#pragma unroll
                    for (int m = 0; m < 4; ++m) acc[ai][bj][m][n] += bv; }
        const bool bad = st.run(acc, u, wr, wc, fr, fq, lds, wid, lane) || poison != 0u;
        const float qnan = __builtin_nanf("");
#pragma unroll
        for (int ai = 0; ai < 2; ++ai)
#pragma unroll
            for (int m = 0; m < 4; ++m) { const int r = ai * HALF + wr * 64 + m * 16 + fr; const f32x2v sr = S[r]; const size_t off = (size_t)(u.pm * BM + r) * ldc + col0;
#pragma unroll
                for (int bj = 0; bj < 2; ++bj)
#pragma unroll
                    for (int n = 0; n < 2; ++n) { const f32x4 bs = *(const f32x4*)(base + off + bj * HALF + n * 16); f32x4 o = bs + (acc[ai][bj][m][n] - sr.x) * sr.y;
                        if (bad) o = (f32x4){qnan, qnan, qnan, qnan}; *(f32x4*)(out + off + bj * HALF + n * 16) = o; }
                asm volatile("" ::: "memory"); }
    }
};
struct EpiLnResLn {
    static constexpr bool PERM = false, AFTER_DRAIN = true;
    const float* base; float* out; bf16_t* xn; int ldc; const float* bias; PanelStats st1, st2; unsigned poison;
    __device__ __forceinline__ void refuse(size_t i0, size_t stride, int M, int N) const { const float q = __builtin_nanf(""); for (size_t i = i0; i < (size_t)M * N; i += stride) { const size_t o = (i / N) * ldc + i % N; out[o] = q; xn[o] = (bf16_t)0x7fc0u; }
        if (i0 == 0) { unsigned expect = 0u; __hip_atomic_compare_exchange_strong(st1.tmo + 1, &expect, 0x7f0u, __ATOMIC_RELAXED, __ATOMIC_RELAXED, __HIP_MEMORY_SCOPE_AGENT); __hip_atomic_store(st1.tmo, 1u, __ATOMIC_RELAXED, __HIP_MEMORY_SCOPE_AGENT); } }
    __device__ __forceinline__ void fused(f32x4 (&acc)[2][2][4][2], const Unit& u, int wr, int wc, int fr, int fq, PG8_LAS unsigned char* lds, int wid, int lane) const {
        typedef float f32x2v __attribute__((ext_vector_type(2))); typedef unsigned u32x2v __attribute__((ext_vector_type(2)));
        const PG8_LAS f32x2v* S = (const PG8_LAS f32x2v*)(lds + 8192);
        const int col0 = u.pn * BM + wc * 32 + 4 * fq;
#pragma unroll
        for (int bj = 0; bj < 2; ++bj)
#pragma unroll
            for (int n = 0; n < 2; ++n) { const f32x4 bv = bias ? *(const f32x4*)(bias + col0 + bj * HALF + n * 16) : (f32x4){0.f, 0.f, 0.f, 0.f};
#pragma unroll
                for (int ai = 0; ai < 2; ++ai)
#pragma unroll
                    for (int m = 0; m < 4; ++m) acc[ai][bj][m][n] += bv; }
        bool bad = st1.run(acc, u, wr, wc, fr, fq, lds, wid, lane) || poison != 0u;
        const float qnan = __builtin_nanf("");
#pragma unroll
        for (int ai = 0; ai < 2; ++ai)
#pragma unroll
            for (int m = 0; m < 4; ++m) { const int r = ai * HALF + wr * 64 + m * 16 + fr; const f32x2v sr = S[r]; const size_t off = (size_t)(u.pm * BM + r) * ldc + col0;
#pragma unroll
                for (int bj = 0; bj < 2; ++bj)
#pragma unroll
                    for (int n = 0; n < 2; ++n) { const f32x4 bs = *(const f32x4*)(base + off + bj * HALF + n * 16); acc[ai][bj][m][n] = bs + (acc[ai][bj][m][n] - sr.x) * sr.y; }
                asm volatile("" : "+v"(acc[ai][0][m][0]), "+v"(acc[ai][0][m][1]), "+v"(acc[ai][1][m][0]), "+v"(acc[ai][1][m][1]));
                if (m & 1) asm volatile("" ::: "memory"); }
        const bool bad1 = bad;
        bad = st2.run(acc, u, wr, wc, fr, fq, lds, wid, lane) || bad;
#pragma unroll
        for (int ai = 0; ai < 2; ++ai)
#pragma unroll
            for (int m = 0; m < 4; ++m) { const int r = ai * HALF + wr * 64 + m * 16 + fr; const f32x2v sr = S[r]; const size_t off = (size_t)(u.pm * BM + r) * ldc + col0;
#pragma unroll
                for (int bj = 0; bj < 2; ++bj)
#pragma unroll
                    for (int n = 0; n < 2; ++n) { const f32x4 x1 = acc[ai][bj][m][n]; *(f32x4*)(out + off + bj * HALF + n * 16) = bad1 ? (f32x4){qnan, qnan, qnan, qnan} : x1;
                        const f32x4 o = (x1 - sr.x) * sr.y; u32x2v w; w.x = cvt_pk_bf16(o[0], o[1]); w.y = cvt_pk_bf16(o[2], o[3]);
                        if (bad) { w.x = 0x7fc07fc0u; w.y = 0x7fc07fc0u; } *(u32x2v*)(xn + off + bj * HALF + n * 16) = w; }
                asm volatile("" ::: "memory"); }
    }
};

template <class Epi, class Sched, bool STAMP = false>
__device__ __forceinline__ void gemm_phase(PG8_LAS unsigned char* lds, const Gemm g, const Sched& S, const Epi& E, unsigned long long* stamps) {
    int tid = threadIdx.x; asm volatile("" : "+v"(tid)); const int wid = __builtin_amdgcn_readfirstlane(tid >> 6), lane = tid & 63, wr = wid >> 2, wc = wid & 3, fr = lane & 15, fq = lane >> 4;
    const int K = g.K, nt = K / BK;
    int ts_lo = 0, ts_hi = 0, nts = 0; const unsigned long long rt_entry = STAMP ? (unsigned long long)wall_clock64() : 0ull;
#define PG8_STAMP() do { if (STAMP && wid == 0 && nts < 64) { const unsigned long long _c = (unsigned long long)clock64(); \
        ts_lo = (lane == nts) ? (int)(unsigned)_c : ts_lo; ts_hi = (lane == nts) ? (int)(unsigned)(_c >> 32) : ts_hi; ++nts; } } while (0)
    PG8_STAMP();
    unsigned voffA[2], voffB[2];
#pragma unroll
    for (int i = 0; i < 2; ++i) { int R, C; stage_rc(tid * 16 + i * 8192, R, C); const int Rb = Epi::PERM ? ((R & ~31) + perm32(R & 31)) : R;
        voffA[i] = (unsigned)(R * K + C) * 2u; voffB[i] = (unsigned)(Rb * K + C) * 2u; }
    const size_t kstep = (size_t)(BK * 2);
    const size_t hstep = (size_t)HALF * K * 2;
    const size_t tstep = 2 * hstep;
    const unsigned ldsw = (unsigned)wid * 1024u;
    const int aoff = lds_byte(wr * 64 + fr, fq * 8), boff = lds_byte(wc * 32 + fr, fq * 8);
#define PG8_SA(b, h) (((b) * 2 + (h)) * HTB)
#define PG8_SB(b, h) ((4 + (b) * 2 + (h)) * HTB)
#define PG8_STAGE(bufoff, gbase, voff) do { _Pragma("unroll") for (int _i = 0; _i < 2; ++_i) \
        __builtin_amdgcn_global_load_lds((const unsigned*)((const char*)(gbase) + (voff)[_i]), (PG8_LAS unsigned*)(lds + (bufoff) + ldsw + _i * 8192), 16, 0, 0); } while (0)
#define PG8_LDA(dst, b, h) do { _Pragma("unroll") for (int m = 0; m < 4; ++m) _Pragma("unroll") for (int k = 0; k < 2; ++k) dst[m][k] = *(const PG8_LAS bf16x8*)(lds + PG8_SA(b, h) + aoff + m * 2048 + k * 1024); } while (0)
#define PG8_LDB(dst, b, h) do { _Pragma("unroll") for (int n = 0; n < 2; ++n) _Pragma("unroll") for (int k = 0; k < 2; ++k) dst[n][k] = *(const PG8_LAS bf16x8*)(lds + PG8_SB(b, h) + boff + n * 2048 + k * 1024); } while (0)
#define PG8_MMA(ai, bj, At, Bt) do { __builtin_amdgcn_s_setprio(1); _Pragma("unroll") for (int m = 0; m < 4; ++m) _Pragma("unroll") for (int n = 0; n < 2; ++n) _Pragma("unroll") for (int k = 0; k < 2; ++k) \
        acc[ai][bj][m][n] = __builtin_amdgcn_mfma_f32_16x16x32_bf16(Bt[n][k], At[m][k], acc[ai][bj][m][n], 0, 0, 0); __builtin_amdgcn_s_setprio(0); } while (0)
#define PG8_WAIT_V(n) asm volatile("s_waitcnt vmcnt(" #n ")" ::: "memory")
#define PG8_WAIT_L(n) asm volatile("s_waitcnt lgkmcnt(" #n ")" ::: "memory")
#define PG8_BAR __builtin_amdgcn_s_barrier()
#define PG8_SCHED __builtin_amdgcn_sched_barrier(0)
    Unit cur, nxt; int ui = 0;
    if (!S.next(0, cur)) return;
    f32x4 acc[2][2][4][2];
#pragma unroll
    for (int a = 0; a < 2; ++a)
#pragma unroll
        for (int b = 0; b < 2; ++b)
#pragma unroll
            for (int m = 0; m < 4; ++m)
#pragma unroll
                for (int n = 0; n < 2; ++n) acc[a][b][m][n] = (f32x4){0.f, 0.f, 0.f, 0.f};
    bf16x8 At[4][2], B0[2][2], B1[2][2];
    const char* cA = (const char*)g.A + (size_t)cur.pm * tstep; const char* cB = (const char*)g.Bt + (size_t)cur.pn * tstep;
    S.a_ready(cur);
    PG8_STAGE(PG8_SB(0, 0), cB, voffB); PG8_STAGE(PG8_SA(0, 0), cA, voffA); PG8_STAGE(PG8_SB(0, 1), cB + hstep, voffB); PG8_STAGE(PG8_SA(0, 1), cA + hstep, voffA);
    if (wr == 1) PG8_BAR;
    PG8_WAIT_V(4); PG8_BAR;
    PG8_STAGE(PG8_SB(1, 0), cB + kstep, voffB); PG8_STAGE(PG8_SA(1, 0), cA + kstep, voffA); PG8_STAGE(PG8_SB(1, 1), cB + hstep + kstep, voffB);
    PG8_WAIT_V(6); PG8_BAR;
    PG8_STAMP();
    for (;;) {
        const bool has_next = S.next(ui + 1, nxt);
        const char* nA = has_next ? (const char*)g.A + (size_t)nxt.pm * tstep : cA; const char* nB = has_next ? (const char*)g.Bt + (size_t)nxt.pn * tstep : cB;
        for (int t = 0; t < nt; t += 2) {
            const bool last = (t == nt - 2);
            const char* a1 = cA + (size_t)(t + 1) * kstep;
            const char* a2 = last ? nA : cA + (size_t)(t + 2) * kstep; const char* b2 = last ? nB : cB + (size_t)(t + 2) * kstep;
            const char* a3 = a2 + kstep; const char* b3 = b2 + kstep;
            if (last && has_next) S.a_ready(nxt);
            PG8_LDB(B0, 0, 0); PG8_SCHED; PG8_LDA(At, 0, 0); PG8_STAGE(PG8_SA(1, 1), a1 + hstep, voffA);
            PG8_WAIT_L(8); PG8_BAR; PG8_WAIT_L(0); PG8_MMA(0, 0, At, B0); PG8_BAR; PG8_SCHED;
            PG8_LDB(B1, 0, 1); PG8_STAGE(PG8_SB(0, 0), b2, voffB);
            PG8_BAR; PG8_WAIT_L(0); PG8_MMA(0, 1, At, B1); PG8_BAR;
            PG8_LDA(At, 0, 1); PG8_STAGE(PG8_SA(0, 0), a2, voffA);
            PG8_BAR; PG8_WAIT_L(0); PG8_MMA(1, 0, At, B0); PG8_BAR; PG8_SCHED;
            PG8_STAGE(PG8_SB(0, 1), b2 + hstep, voffB);
            PG8_WAIT_V(6); PG8_BAR; PG8_MMA(1, 1, At, B1); PG8_BAR;
            PG8_LDB(B0, 1, 0); PG8_SCHED; PG8_LDA(At, 1, 0); PG8_STAGE(PG8_SA(0, 1), a2 + hstep, voffA);
            PG8_WAIT_L(8); PG8_BAR; PG8_WAIT_L(0); PG8_MMA(0, 0, At, B0); PG8_BAR; PG8_SCHED;
            PG8_LDB(B1, 1, 1); PG8_STAGE(PG8_SB(1, 0), b3, voffB);
            PG8_BAR; PG8_WAIT_L(0); PG8_MMA(0, 1, At, B1); PG8_BAR;
            PG8_LDA(At, 1, 1); PG8_STAGE(PG8_SA(1, 0), a3, voffA);
            PG8_BAR; PG8_WAIT_L(0); PG8_MMA(1, 0, At, B0); PG8_BAR; PG8_SCHED;
            PG8_STAGE(PG8_SB(1, 1), b3 + hstep, voffB);
            PG8_WAIT_V(6); PG8_BAR; PG8_MMA(1, 1, At, B1); PG8_BAR;
        }
        PG8_STAMP();
        if constexpr (!Epi::AFTER_DRAIN) { E(acc, cur, wr, wc, fr, fq); S.done(cur); }
        PG8_STAMP();
        if (!has_next) break;
#pragma unroll
        for (int a = 0; a < 2; ++a)
#pragma unroll
            for (int b = 0; b < 2; ++b)
#pragma unroll
                for (int m = 0; m < 4; ++m)
#pragma unroll
                    for (int n = 0; n < 2; ++n) acc[a][b][m][n] = (f32x4){0.f, 0.f, 0.f, 0.f};
        cur = nxt; cA = nA; cB = nB; ++ui;
    }
    PG8_WAIT_V(0);
    if (wr == 0) PG8_BAR;
    PG8_BAR;
    if constexpr (Epi::AFTER_DRAIN) { E.fused(acc, cur, wr, wc, fr, fq, lds, wid, lane); S.done(cur); }
    PG8_STAMP();
    if (STAMP && wid == 0) { stamps[lane] = lane < nts ? (((unsigned long long)(unsigned)ts_hi << 32) | (unsigned)ts_lo) : 0ull;
        if (lane == 62) stamps[62] = rt_entry; if (lane == 63) stamps[63] = (unsigned long long)wall_clock64(); }
#undef PG8_STAMP
#undef PG8_SA
#undef PG8_SB
#undef PG8_STAGE
#undef PG8_LDA
#undef PG8_LDB
#undef PG8_MMA
#undef PG8_WAIT_V
#undef PG8_WAIT_L
#undef PG8_BAR
#undef PG8_SCHED
}
}

namespace mk {
using pg8::bf16_t; using pg8::bf16x8; using pg8::f32x4; using pg8::u32x4; using pg8::Unit; using pg8::cvt_pk_bf16;
typedef unsigned u32x2 __attribute__((ext_vector_type(2)));
typedef PG8_LAS float* ldsf;
constexpr int M = 49152, MP = 32768, D = 1024, DFF = 2816, NMEM = 5120, NL = 4, NPH = 19;
constexpr float ALPHA = 1.6817928305074292f;
constexpr int LDS_BYTES = 147456;

constexpr size_t W_GU1 = 0, W_D1 = W_GU1 + 5632ull * 1024, W_INA = W_D1 + 1024ull * 2816, W_INM = W_INA + 3328ull * 1024, W_CO = W_INM + 2048ull * 1024,
                 W_GO = W_CO + 1024ull * 512, W_OUT = W_GO + 1024ull * 512, W_Q = W_OUT + 1024ull * 1024, W_K = W_Q + 1024ull * 1024, W_V = W_K + 1024ull * 1024,
                 W_O = W_V + 1024ull * 1024, W_GU2 = W_O + 1024ull * 1024, W_D2 = W_GU2 + 5632ull * 1024, W_END = W_D2 + 1024ull * 2816;
constexpr size_t SZ512 = (size_t)M * 512 * 2;
constexpr size_t OFF_W = 4096, OFF_XB = OFF_W + W_END * 2, OFF_HC = OFF_XB + (size_t)M * 1024 * 2, OFF_GB = OFF_HC + SZ512, OFF_GC = OFF_GB + SZ512,
                 OFF_QK = OFF_GC + SZ512, OFF_V = OFF_QK + SZ512, OFF_G = OFF_V + SZ512, OFF_LR = OFF_G + SZ512, OFF_OF = OFF_LR + (size_t)M * 32 * 4,
                 OFF_AGLA = OFF_OF + (size_t)M * 512 * 4, OFF_MEMB = OFF_AGLA + SZ512, OFF_KM = OFF_MEMB + (size_t)NMEM * 1024 * 2, OFF_VT = OFF_KM + (size_t)NMEM * 1024 * 2,
                 OFF_DCH = OFF_VT + (size_t)NMEM * 1024 * 2, WS_END = OFF_DCH + (size_t)6144 * 64 * 4;

struct Params {
    const float* in[21];
    float* out; unsigned char* ws;
    int ph_lo, ph_hi, coop, pad;
};

__device__ __forceinline__ float bf_lo(unsigned w) { return __uint_as_float(w << 16); }
__device__ __forceinline__ float bf_hi(unsigned w) { return __uint_as_float(w & 0xffff0000u); }
__device__ __forceinline__ float bf2f(bf16_t b) { return __uint_as_float(((unsigned)b) << 16); }
__device__ __forceinline__ float sigm(float x) { return 1.0f / (1.0f + __expf(-x)); }
__device__ __forceinline__ float silu(float x) { return x / (1.0f + __expf(-x)); }
__device__ __forceinline__ float wave_sum(float v) {
#pragma unroll
    for (int o = 32; o >= 1; o >>= 1) v += __shfl_xor(v, o);
    return v;
}

struct EpiSwiglu {
    static constexpr bool PERM = true, AFTER_DRAIN = false;
    bf16_t* H;
    __device__ __forceinline__ void operator()(const f32x4 (&acc)[2][2][4][2], const Unit& u, int wr, int wc, int fr, int fq) const {
        const int row0 = u.pm * 256 + wr * 64 + fr, col0 = u.pn * 128 + wc * 32 + 8 * fq;
#pragma unroll
        for (int ai = 0; ai < 2; ++ai)
#pragma unroll
            for (int m = 0; m < 4; ++m) {
                bf16_t* rowp = H + (size_t)(row0 + ai * 128 + m * 16) * DFF + col0;
                f32x4 v0, v1;
#pragma unroll
                for (int j = 0; j < 4; ++j) { v0[j] = silu(acc[ai][0][m][0][j]) * acc[ai][1][m][0][j]; v1[j] = silu(acc[ai][0][m][1][j]) * acc[ai][1][m][1][j]; }
                u32x4 w; w.x = cvt_pk_bf16(v0[0], v0[1]); w.y = cvt_pk_bf16(v0[2], v0[3]); w.z = cvt_pk_bf16(v1[0], v1[1]); w.w = cvt_pk_bf16(v1[2], v1[3]);
                *(u32x4*)rowp = w;
            }
    }
};
struct EpiResid {
    static constexpr bool PERM = false, AFTER_DRAIN = false;
    float* X; float s;
    __device__ __forceinline__ void operator()(const f32x4 (&acc)[2][2][4][2], const Unit& u, int wr, int wc, int fr, int fq) const {
        const int row0 = u.pm * 256 + wr * 64 + fr, col0 = u.pn * 256 + wc * 32 + 4 * fq;
#pragma unroll
        for (int ai = 0; ai < 2; ++ai)
#pragma unroll
            for (int m = 0; m < 4; ++m) {
                float* rowp = X + (size_t)(row0 + ai * 128 + m * 16) * D + col0;
#pragma unroll
                for (int bj = 0; bj < 2; ++bj)
#pragma unroll
                    for (int n = 0; n < 2; ++n) { float* q = rowp + bj * 128 + n * 16; const f32x4 x = *(const f32x4*)q; *(f32x4*)q = x * ALPHA + acc[ai][bj][m][n] * s; }
            }
    }
};
struct EpiRoute {
    static constexpr bool PERM = true, AFTER_DRAIN = false;
    bf16_t* base; int ld; int tpb; size_t bstride; float* lr; int lr_tile;
    __device__ __forceinline__ void operator()(const f32x4 (&acc)[2][2][4][2], const Unit& u, int wr, int wc, int fr, int fq) const {
        const int row0 = u.pm * 256 + wr * 64 + fr;
        if (u.pn == lr_tile) {
            if (wc == 0) {
#pragma unroll
                for (int ai = 0; ai < 2; ++ai)
#pragma unroll
                    for (int m = 0; m < 4; ++m) {
                        float* rowp = lr + (size_t)(row0 + ai * 128 + m * 16) * 32 + 8 * fq;
                        *(f32x4*)rowp = acc[ai][0][m][0]; *(f32x4*)(rowp + 4) = acc[ai][0][m][1];
                    }
            }
            return;
        }
        const int b = tpb ? u.pn / tpb : 0; const int colt = (tpb ? (u.pn - b * tpb) : u.pn) * 256;
        bf16_t* dst = base + (size_t)b * bstride; const int col0 = colt + wc * 32 + 8 * fq;
#pragma unroll
        for (int ai = 0; ai < 2; ++ai)
#pragma unroll
            for (int m = 0; m < 4; ++m) {
                bf16_t* rowp = dst + (size_t)(row0 + ai * 128 + m * 16) * ld + col0;
#pragma unroll
                for (int bj = 0; bj < 2; ++bj) {
                    const f32x4 v0 = acc[ai][bj][m][0], v1 = acc[ai][bj][m][1];
                    u32x4 w; w.x = cvt_pk_bf16(v0[0], v0[1]); w.y = cvt_pk_bf16(v0[2], v0[3]); w.z = cvt_pk_bf16(v1[0], v1[1]); w.w = cvt_pk_bf16(v1[2], v1[3]);
                    *(u32x4*)(rowp + bj * 128) = w;
                }
            }
    }
};
struct EpiMerge {
    static constexpr bool PERM = true, AFTER_DRAIN = false;
    const bf16_t* YC; const bf16_t* YG; bf16_t* MG;
    __device__ __forceinline__ void operator()(const f32x4 (&acc)[2][2][4][2], const Unit& u, int wr, int wc, int fr, int fq) const {
        const int row0 = u.pm * 256 + wr * 64 + fr, col0 = u.pn * 128 + wc * 32 + 8 * fq;
#pragma unroll
        for (int ai = 0; ai < 2; ++ai)
#pragma unroll
            for (int m = 0; m < 4; ++m) {
                const size_t off = (size_t)(row0 + ai * 128 + m * 16) * D + col0;
                const u32x4 yc = *(const u32x4*)(YC + off), yg = *(const u32x4*)(YG + off);
                const f32x4 c0 = acc[ai][0][m][0], c1 = acc[ai][0][m][1], g0 = acc[ai][1][m][0], g1 = acc[ai][1][m][1];
                u32x4 w;
                w.x = cvt_pk_bf16(sigm(c0[0]) * bf_lo(yc.x) + sigm(g0[0]) * bf_lo(yg.x), sigm(c0[1]) * bf_hi(yc.x) + sigm(g0[1]) * bf_hi(yg.x));
                w.y = cvt_pk_bf16(sigm(c0[2]) * bf_lo(yc.y) + sigm(g0[2]) * bf_lo(yg.y), sigm(c0[3]) * bf_hi(yc.y) + sigm(g0[3]) * bf_hi(yg.y));
                w.z = cvt_pk_bf16(sigm(c1[0]) * bf_lo(yc.z) + sigm(g1[0]) * bf_lo(yg.z), sigm(c1[1]) * bf_hi(yc.z) + sigm(g1[1]) * bf_hi(yg.z));
                w.w = cvt_pk_bf16(sigm(c1[2]) * bf_lo(yc.w) + sigm(g1[2]) * bf_lo(yg.w), sigm(c1[3]) * bf_hi(yc.w) + sigm(g1[3]) * bf_hi(yg.w));
                *(u32x4*)(MG + off) = w;
            }
    }
};

template <class E>
__device__ __forceinline__ void run_gemm(PG8_LAS unsigned char* lds, const bf16_t* A, const bf16_t* Bt, int Mr, int N, int K, const E& e, int cshift) {
    pg8::Gemm g{A, Bt, Mr, N, K}; pg8::StaticOrder S; S.init(Mr, N, (int)gridDim.x, (int)((blockIdx.x + cshift) % gridDim.x));
    pg8::gemm_phase<E, pg8::StaticOrder, false>(lds, g, S, e, nullptr);
}

__device__ __forceinline__ int wmap(int mode, int n) {
    if (mode == 0) return n;
    if (mode == 1) { const int p = n >> 8, s = (n >> 7) & 1, j = n & 127; return s * DFF + 128 * p + j; }
    if (mode == 2) return n < 3104 ? n : -1;
    if (mode == 3) { const int p = n >> 8, s = (n >> 7) & 1, j = n & 127; return 3104 + s * 1024 + 128 * p + j; }
    return 1024 + n;
}
__device__ __forceinline__ void wprep_tile(PG8_LAS unsigned char* lds, const float* W, bf16_t* Wt, int K, int Nsrc, int mode, int tn, int tk) {
    ldsf T = (ldsf)lds;
    int tid = threadIdx.x; asm volatile("" : "+v"(tid));
    { const int tx = tid & 63, ty = tid >> 6; const int src = wmap(mode, tn * 64 + tx);
#pragma unroll
      for (int i = 0; i < 8; ++i) { const int kk = ty + i * 8; T[kk * 65 + tx] = src >= 0 ? W[(size_t)(tk * 64 + kk) * Nsrc + src] : 0.f; } }
    __syncthreads();
    { const int kx = tid & 31, ny = tid >> 5;
#pragma unroll
      for (int i = 0; i < 4; ++i) { const int nn = ny + i * 16; const unsigned w = cvt_pk_bf16(T[(2 * kx) * 65 + nn], T[(2 * kx + 1) * 65 + nn]);
          *(unsigned*)(Wt + (size_t)(tn * 64 + nn) * K + tk * 64 + 2 * kx) = w; } }
    __syncthreads();
}
__device__ __forceinline__ void phase_wprep(const Params& p, PG8_LAS unsigned char* lds, int l) {
    bf16_t* Wb = (bf16_t*)(p.ws + OFF_W);
    for (int t = blockIdx.x; t < 7104; t += gridDim.x) {
        const float* src; bf16_t* dst; int K, Nsrc, mode, base;
        if (t < 1408)      { src = p.in[4] + (size_t)l * 1024 * 5632;  dst = Wb + W_GU1; K = 1024; Nsrc = 5632; mode = 1; base = 0; }
        else if (t < 2112) { src = p.in[5] + (size_t)l * 2816 * 1024;  dst = Wb + W_D1;  K = 2816; Nsrc = 1024; mode = 0; base = 1408; }
        else if (t < 2944) { src = p.in[6] + (size_t)l * 1024 * 5152;  dst = Wb + W_INA; K = 1024; Nsrc = 5152; mode = 2; base = 2112; }
        else if (t < 3456) { src = p.in[6] + (size_t)l * 1024 * 5152;  dst = Wb + W_INM; K = 1024; Nsrc = 5152; mode = 3; base = 2944; }
        else if (t < 3584) { src = p.in[8] + (size_t)l * 512 * 1024;   dst = Wb + W_CO;  K = 512;  Nsrc = 1024; mode = 0; base = 3456; }
        else if (t < 3712) { src = p.in[12] + (size_t)l * 512 * 1024;  dst = Wb + W_GO;  K = 512;  Nsrc = 1024; mode = 0; base = 3584; }
        else if (t < 3968) { src = p.in[13] + (size_t)l * 1024 * 1024; dst = Wb + W_OUT; K = 1024; Nsrc = 1024; mode = 0; base = 3712; }
        else if (t < 4224) { src = p.in[14] + (size_t)l * 1024 * 1024; dst = Wb + W_Q;   K = 1024; Nsrc = 1024; mode = 0; base = 3968; }
        else if (t < 4480) { src = p.in[15] + (size_t)l * 1024 * 2048; dst = Wb + W_K;   K = 1024; Nsrc = 2048; mode = 0; base = 4224; }
        else if (t < 4736) { src = p.in[15] + (size_t)l * 1024 * 2048; dst = Wb + W_V;   K = 1024; Nsrc = 2048; mode = 4; base = 4480; }
        else if (t < 4992) { src = p.in[16] + (size_t)l * 1024 * 1024; dst = Wb + W_O;   K = 1024; Nsrc = 1024; mode = 0; base = 4736; }
        else if (t < 6400) { src = p.in[17] + (size_t)l * 1024 * 5632; dst = Wb + W_GU2; K = 1024; Nsrc = 5632; mode = 1; base = 4992; }
        else               { src = p.in[18] + (size_t)l * 2816 * 1024; dst = Wb + W_D2;  K = 2816; Nsrc = 1024; mode = 0; base = 6400; }
        const int ti = t - base, ntk = K >> 6;
        wprep_tile(lds, src, dst, K, Nsrc, mode, ti / ntk, ti % ntk);
    }
}
__device__ __forceinline__ void phase_prologue(const Params& p) {
    float* X = p.out; bf16_t* XB = (bf16_t*)(p.ws + OFF_XB); bf16_t* MEMB = (bf16_t*)(p.ws + OFF_MEMB);
    int tid = threadIdx.x; asm volatile("" : "+v"(tid)); const size_t nth = (size_t)gridDim.x * 512, t0 = (size_t)blockIdx.x * 512 + tid;
    const size_t n4 = (size_t)M * D / 4, np4 = (size_t)MP * D / 4;
    for (size_t i = t0; i < n4; i += nth) {
        const f32x4 v = i < np4 ? ((const f32x4*)p.in[0])[i] : ((const f32x4*)p.in[1])[i - np4];
        ((f32x4*)X)[i] = v; u32x2 w; w.x = cvt_pk_bf16(v[0], v[1]); w.y = cvt_pk_bf16(v[2], v[3]); ((u32x2*)XB)[i] = w;
    }
    const size_t m4 = (size_t)NMEM * D / 4, mp4 = (size_t)16 * 256 * D / 4;
    for (size_t i = t0; i < m4; i += nth) {
        const f32x4 v = i < mp4 ? ((const f32x4*)p.in[2])[i] : ((const f32x4*)p.in[3])[i - mp4];
        u32x2 w; w.x = cvt_pk_bf16(v[0], v[1]); w.y = cvt_pk_bf16(v[2], v[3]); ((u32x2*)MEMB)[i] = w;
    }
}
__device__ __forceinline__ void phase_ln(const Params& p, int l, int k) {
    float* X = p.out; bf16_t* XB = (bf16_t*)(p.ws + OFF_XB);
    const float* g = p.in[19] + (size_t)(l * 4 + k) * D; const float* b = p.in[20] + (size_t)(l * 4 + k) * D;
    int tid = threadIdx.x; asm volatile("" : "+v"(tid)); const int lane = tid & 63, wid = tid >> 6;
    f32x4 gv[4], bv[4];
#pragma unroll
    for (int i = 0; i < 4; ++i) { gv[i] = *(const f32x4*)(g + i * 256 + lane * 4); bv[i] = *(const f32x4*)(b + i * 256 + lane * 4); }
    for (int row = blockIdx.x * 8 + wid; row < M; row += gridDim.x * 8) {
        float* xr = X + (size_t)row * D; f32x4 v[4]; float s = 0.f;
#pragma unroll
        for (int i = 0; i < 4; ++i) { v[i] = *(const f32x4*)(xr + i * 256 + lane * 4); s += (v[i][0] + v[i][1]) + (v[i][2] + v[i][3]); }
        const float mean = wave_sum(s) * (1.0f / 1024.0f); float q = 0.f;
#pragma unroll
        for (int i = 0; i < 4; ++i) { const f32x4 d = v[i] - mean; q += (d[0] * d[0] + d[1] * d[1]) + (d[2] * d[2] + d[3] * d[3]); }
        const float rstd = rsqrtf(wave_sum(q) * (1.0f / 1024.0f) + 1e-5f);
#pragma unroll
        for (int i = 0; i < 4; ++i) { const f32x4 y = (v[i] - mean) * rstd * gv[i] + bv[i]; *(f32x4*)(xr + i * 256 + lane * 4) = y;
            u32x2 w; w.x = cvt_pk_bf16(y[0], y[1]); w.y = cvt_pk_bf16(y[2], y[3]); *(u32x2*)(XB + (size_t)row * D + i * 256 + lane * 4) = w; }
    }
}
__device__ __forceinline__ void phase_conv(const Params& p, int l, int worker, int nworkers) {
    const bf16_t* HC = (const bf16_t*)(p.ws + OFF_HC); bf16_t* GB = (bf16_t*)(p.ws + OFF_GB); const bf16_t* GC = (const bf16_t*)(p.ws + OFF_GC);
    const float* cw = p.in[7] + (size_t)l * 3 * 512;
    int tid = threadIdx.x; asm volatile("" : "+v"(tid));
    for (size_t i = (size_t)worker * 512 + tid; i < (size_t)M * 64; i += (size_t)nworkers * 512) {
        const int row = (int)(i >> 6), c8 = (int)(i & 63) * 8;
        int t, T; if (row < MP) { t = row & 2047; T = 2048; } else { t = (row - MP) & 4095; T = 4096; }
        const size_t o = (size_t)row * 512 + c8;
        const u32x4 z4 = {0u, 0u, 0u, 0u};
        const u32x4 h1 = *(const u32x4*)(HC + o), g1 = *(const u32x4*)(GC + o), gb = *(const u32x4*)(GB + o);
        const u32x4 h0 = t > 0 ? *(const u32x4*)(HC + o - 512) : z4, g0 = t > 0 ? *(const u32x4*)(GC + o - 512) : z4;
        const u32x4 h2 = t < T - 1 ? *(const u32x4*)(HC + o + 512) : z4, g2 = t < T - 1 ? *(const u32x4*)(GC + o + 512) : z4;
        const f32x4 w0a = *(const f32x4*)(cw + c8), w0b = *(const f32x4*)(cw + c8 + 4), w1a = *(const f32x4*)(cw + 512 + c8), w1b = *(const f32x4*)(cw + 512 + c8 + 4),
                    w2a = *(const f32x4*)(cw + 1024 + c8), w2b = *(const f32x4*)(cw + 1024 + c8 + 4);
        u32x4 r;
        float wv0[8] = {w0a[0], w0a[1], w0a[2], w0a[3], w0b[0], w0b[1], w0b[2], w0b[3]};
        float wv1[8] = {w1a[0], w1a[1], w1a[2], w1a[3], w1b[0], w1b[1], w1b[2], w1b[3]};
        float wv2[8] = {w2a[0], w2a[1], w2a[2], w2a[3], w2b[0], w2b[1], w2b[2], w2b[3]};
        const unsigned hw0[4] = {h0.x, h0.y, h0.z, h0.w}, gw0[4] = {g0.x, g0.y, g0.z, g0.w}, hw1[4] = {h1.x, h1.y, h1.z, h1.w}, gw1[4] = {g1.x, g1.y, g1.z, g1.w},
                       hw2[4] = {h2.x, h2.y, h2.z, h2.w}, gw2[4] = {g2.x, g2.y, g2.z, g2.w}, gbw[4] = {gb.x, gb.y, gb.z, gb.w};
        unsigned rw[4];
#pragma unroll
        for (int k = 0; k < 4; ++k) {
            const float lo = bf_lo(gbw[k]) * (wv0[2 * k] * (bf_lo(hw0[k]) * bf_lo(gw0[k])) + wv1[2 * k] * (bf_lo(hw1[k]) * bf_lo(gw1[k])) + wv2[2 * k] * (bf_lo(hw2[k]) * bf_lo(gw2[k])));
            const float hi = bf_hi(gbw[k]) * (wv0[2 * k + 1] * (bf_hi(hw0[k]) * bf_hi(gw0[k])) + wv1[2 * k + 1] * (bf_hi(hw1[k]) * bf_hi(gw1[k])) + wv2[2 * k + 1] * (bf_hi(hw2[k]) * bf_hi(gw2[k])));
            rw[k] = cvt_pk_bf16(lo, hi);
        }
        r.x = rw[0]; r.y = rw[1]; r.z = rw[2]; r.w = rw[3];
        *(u32x4*)(GB + o) = r;
    }
}

__device__ __forceinline__ float lsig2(float z) { return (fminf(z, 0.f) - __logf(1.0f + __expf(-fabsf(z)))) * (0.0625f * 1.44269504088896f); }

template <int MODE>
__device__ __forceinline__ void gla_chunk(const Params& p, PG8_LAS unsigned char* lds, int l, int item) {
    typedef pg8::f32x2 f32x2;
    int tid = threadIdx.x; asm volatile("" : "+v"(tid));
    const int lane = tid & 63, w = tid >> 6, fr = lane & 15, fq = lane >> 4;
    const int cgi = item >> 2, h = item & 3, rowb = cgi * 64;
    ldsf sLR = (ldsf)lds; ldsf sTOT = (ldsf)(lds + 8192);
    PG8_LAS bf16_t* sVT = (PG8_LAS bf16_t*)(lds + 12288);
    PG8_LAS bf16_t* sA0 = (PG8_LAS bf16_t*)(lds + 30720);
    PG8_LAS bf16_t* sKIN = (PG8_LAS bf16_t*)(lds + 49152);
    PG8_LAS bf16_t* sQG = (PG8_LAS bf16_t*)(lds + 67584);
    ldsf sSS = (ldsf)(lds + 86016);
    const bf16_t* QK = (const bf16_t*)(p.ws + OFF_QK); const bf16_t* V = (const bf16_t*)(p.ws + OFF_V); const float* LR = (const float*)(p.ws + OFF_LR);
    bf16_t* KV = (bf16_t*)(p.ws + OFF_OF); float* DCH = (float*)(p.ws + OFF_DCH);
    { const f32x4 v = *(const f32x4*)(LR + (size_t)rowb * 32 + tid * 4); *(PG8_LAS f32x4*)(sLR + tid * 4) = v; }
    { const int e = tid & 127, tq = tid >> 7; const bf16_t* vp = V + (size_t)(rowb + tq * 16) * 512 + h * 128 + e;
      unsigned x[16];
#pragma unroll
      for (int i = 0; i < 16; ++i) x[i] = vp[(size_t)i * 512];
      u32x4 w0, w1; w0.x = x[0] | (x[1] << 16); w0.y = x[2] | (x[3] << 16); w0.z = x[4] | (x[5] << 16); w0.w = x[6] | (x[7] << 16);
      w1.x = x[8] | (x[9] << 16); w1.y = x[10] | (x[11] << 16); w1.z = x[12] | (x[13] << 16); w1.w = x[14] | (x[15] << 16);
      *(PG8_LAS u32x4*)(sVT + e * 72 + tq * 16) = w0; *(PG8_LAS u32x4*)(sVT + e * 72 + tq * 16 + 8) = w1; }
    __syncthreads();
    const int dp = tid & 31, dir = (tid >> 5) & 1, oct = tid >> 6, d0 = 2 * dp;
    float p0[8], p1[8];
    {
        const float* w2p = p.in[9] + ((size_t)(l * 2 + dir) * 16) * 256 + h * 64 + d0;
        const f32x2 bias = *(const f32x2*)(p.in[10] + (size_t)(l * 2 + dir) * 256 + h * 64 + d0);
        float wa[16], wb[16];
#pragma unroll
        for (int r = 0; r < 16; ++r) { const f32x2 t = *(const f32x2*)(w2p + r * 256); wa[r] = t.x; wb[r] = t.y; }
        float la0[8], la1[8];
#pragma unroll
        for (int i = 0; i < 8; ++i) {
            const PG8_LAS f32x4* lrp = (const PG8_LAS f32x4*)(sLR + (oct * 8 + i) * 32 + dir * 16);
            float z0 = bias.x, z1 = bias.y;
#pragma unroll
            for (int r4 = 0; r4 < 4; ++r4) { const f32x4 x = lrp[r4];
                z0 += x[0] * wa[r4 * 4] + x[1] * wa[r4 * 4 + 1] + x[2] * wa[r4 * 4 + 2] + x[3] * wa[r4 * 4 + 3];
                z1 += x[0] * wb[r4 * 4] + x[1] * wb[r4 * 4 + 1] + x[2] * wb[r4 * 4 + 2] + x[3] * wb[r4 * 4 + 3]; }
            la0[i] = lsig2(z0); la1[i] = lsig2(z1);
        }
        float r0 = 0.f, r1 = 0.f, f0[8], f1[8];
#pragma unroll
        for (int i = 0; i < 8; ++i) { r0 += la0[i]; r1 += la1[i]; f0[i] = r0; f1[i] = r1; }
#pragma unroll
        for (int i = 0; i < 8; ++i) { p0[i] = dir ? (r0 - f0[i] + la0[i]) : f0[i]; p1[i] = dir ? (r1 - f1[i] + la1[i]) : f1[i]; }
        *(PG8_LAS f32x2*)(sTOT + (dir * 8 + oct) * 64 + d0) = (f32x2){r0, r1};
    }
    __syncthreads();
    float off0 = 0.f, off1 = 0.f, all0 = 0.f, all1 = 0.f, ref0 = 0.f, ref1 = 0.f;
#pragma unroll
    for (int o = 0; o < 8; ++o) {
        const f32x2 tt = *(const PG8_LAS f32x2*)(sTOT + (dir * 8 + o) * 64 + d0);
        all0 += tt.x; all1 += tt.y;
        const bool before = dir ? (o > oct) : (o < oct);
        off0 += before ? tt.x : 0.f; off1 += before ? tt.y : 0.f;
        const bool inref = dir ? (o >= 4) : (o < 4);
        ref0 += inref ? tt.x : 0.f; ref1 += inref ? tt.y : 0.f;
    }
    if (MODE == 1) {
        float v0[8], v1[8];
#pragma unroll
        for (int i = 0; i < 8; ++i) {
            const unsigned kk = *(const unsigned*)(QK + (size_t)(rowb + oct * 8 + i) * 512 + 256 + h * 64 + d0);
            v0[i] = bf_lo(kk) * exp2f(all0 - (off0 + p0[i])); v1[i] = bf_hi(kk) * exp2f(all1 - (off1 + p1[i]));
        }
        u32x4 a, b; a.x = cvt_pk_bf16(v0[0], v0[1]); a.y = cvt_pk_bf16(v0[2], v0[3]); a.z = cvt_pk_bf16(v0[4], v0[5]); a.w = cvt_pk_bf16(v0[6], v0[7]);
        b.x = cvt_pk_bf16(v1[0], v1[1]); b.y = cvt_pk_bf16(v1[2], v1[3]); b.z = cvt_pk_bf16(v1[4], v1[5]); b.w = cvt_pk_bf16(v1[6], v1[7]);
        *(PG8_LAS u32x4*)(sA0 + (dir * 64 + d0) * 72 + oct * 8) = a; *(PG8_LAS u32x4*)(sA0 + (dir * 64 + d0 + 1) * 72 + oct * 8) = b;
        if (oct == 0) *(f32x2*)(DCH + (size_t)(item * 2 + dir) * 64 + d0) = (f32x2){exp2f(all0), exp2f(all1)};
        __syncthreads();
        bf16x8 vb[2];
#pragma unroll
        for (int ks = 0; ks < 2; ++ks) vb[ks] = *(const PG8_LAS bf16x8*)(sVT + (w * 16 + fr) * 72 + ks * 32 + fq * 8);
#pragma unroll
        for (int d2 = 0; d2 < 2; ++d2)
#pragma unroll
            for (int db = 0; db < 4; ++db) {
                f32x4 acc = (f32x4){0.f, 0.f, 0.f, 0.f};
#pragma unroll
                for (int ks = 0; ks < 2; ++ks) { const bf16x8 ka = *(const PG8_LAS bf16x8*)(sA0 + (d2 * 64 + db * 16 + fr) * 72 + ks * 32 + fq * 8); acc = __builtin_amdgcn_mfma_f32_16x16x32_bf16(ka, vb[ks], acc, 0, 0, 0); }
                u32x2 o; o.x = cvt_pk_bf16(acc[0], acc[1]); o.y = cvt_pk_bf16(acc[2], acc[3]);
                *(u32x2*)(KV + (size_t)(item * 2 + d2) * 8192 + (w * 16 + fr) * 64 + db * 16 + fq * 4) = o;
            }
        __syncthreads();
    } else {
        const float er0 = exp2f(ref0), er1 = exp2f(ref1);
#pragma unroll
        for (int i = 0; i < 8; ++i) {
            const int t = oct * 8 + i; const size_t go = (size_t)(rowb + t) * 512 + h * 64 + d0;
            const unsigned qq = *(const unsigned*)(QK + go), kk = *(const unsigned*)(QK + go + 256);
            const float e0 = exp2f(off0 + p0[i] - ref0), e1 = exp2f(off1 + p1[i] - ref1);
            const float qi0 = bf_lo(qq) * 0.125f * e0, qi1 = bf_hi(qq) * 0.125f * e1;
            const float ki0 = bf_lo(kk) * __builtin_amdgcn_rcpf(e0), ki1 = bf_hi(kk) * __builtin_amdgcn_rcpf(e1);
            const int lo = (dir * 64 + t) * 72 + d0;
            *(PG8_LAS unsigned*)(sA0 + lo) = cvt_pk_bf16(qi0, qi1);
            *(PG8_LAS unsigned*)(sKIN + lo) = cvt_pk_bf16(ki0, ki1);
            *(PG8_LAS unsigned*)(sQG + lo) = cvt_pk_bf16(qi0 * er0, qi1 * er1);
        }
        __syncthreads();
        const int ib = w & 3, eh = w >> 2;
        bf16x8 bqf[2], bqb[2], bgf[2], bgb[2];
#pragma unroll
        for (int ks = 0; ks < 2; ++ks) {
            const int of = (ib * 16 + fr) * 72 + ks * 32 + fq * 8, ob = (64 + ib * 16 + fr) * 72 + ks * 32 + fq * 8;
            bqf[ks] = *(const PG8_LAS bf16x8*)(sA0 + of); bqb[ks] = *(const PG8_LAS bf16x8*)(sA0 + ob);
            bgf[ks] = *(const PG8_LAS bf16x8*)(sQG + of); bgb[ks] = *(const PG8_LAS bf16x8*)(sQG + ob);
        }
        f32x4 at[4];
#pragma unroll
        for (int jb = 0; jb < 4; ++jb) {
            f32x4 af = (f32x4){0.f, 0.f, 0.f, 0.f}, ab = (f32x4){0.f, 0.f, 0.f, 0.f};
            if (jb <= ib) {
#pragma unroll
                for (int ks = 0; ks < 2; ++ks) af = __builtin_amdgcn_mfma_f32_16x16x32_bf16(*(const PG8_LAS bf16x8*)(sKIN + (jb * 16 + fr) * 72 + ks * 32 + fq * 8), bqf[ks], af, 0, 0, 0);
            }
            if (jb >= ib) {
#pragma unroll
                for (int ks = 0; ks < 2; ++ks) ab = __builtin_amdgcn_mfma_f32_16x16x32_bf16(*(const PG8_LAS bf16x8*)(sKIN + (64 + jb * 16 + fr) * 72 + ks * 32 + fq * 8), bqb[ks], ab, 0, 0, 0);
            }
#pragma unroll
            for (int r = 0; r < 4; ++r) { const int j = jb * 16 + fq * 4 + r, i = ib * 16 + fr; at[jb][r] = (j <= i) ? af[r] : ab[r]; }
        }
        bf16x8 pfr[2];
#pragma unroll
        for (int s = 0; s < 2; ++s) { u32x4 t; t.x = cvt_pk_bf16(at[2 * s][0], at[2 * s][1]); t.y = cvt_pk_bf16(at[2 * s][2], at[2 * s][3]);
            t.z = cvt_pk_bf16(at[2 * s + 1][0], at[2 * s + 1][1]); t.w = cvt_pk_bf16(at[2 * s + 1][2], at[2 * s + 1][3]); pfr[s] = __builtin_bit_cast(bf16x8, t); }
        const bf16_t* kvf = KV + (size_t)(item * 2) * 8192; const bf16_t* kvb = kvf + 8192;
        f32x4 o[4]; float ss = 0.f;
#pragma unroll
        for (int ebl = 0; ebl < 4; ++ebl) {
            const int er = (eh * 4 + ebl) * 16 + fr; f32x4 acc = (f32x4){0.f, 0.f, 0.f, 0.f};
#pragma unroll
            for (int s = 0; s < 2; ++s) {
                const u32x2 a = *(const PG8_LAS u32x2*)(sVT + er * 72 + (2 * s) * 16 + fq * 4), c = *(const PG8_LAS u32x2*)(sVT + er * 72 + (2 * s + 1) * 16 + fq * 4);
                u32x4 t; t.x = a.x; t.y = a.y; t.z = c.x; t.w = c.y;
                acc = __builtin_amdgcn_mfma_f32_16x16x32_bf16(__builtin_bit_cast(bf16x8, t), pfr[s], acc, 0, 0, 0);
            }
#pragma unroll
            for (int ks = 0; ks < 2; ++ks) {
                const bf16x8 sf = *(const bf16x8*)(kvf + er * 64 + ks * 32 + fq * 8), sb = *(const bf16x8*)(kvb + er * 64 + ks * 32 + fq * 8);
                acc = __builtin_amdgcn_mfma_f32_16x16x32_bf16(sf, bgf[ks], acc, 0, 0, 0);
                acc = __builtin_amdgcn_mfma_f32_16x16x32_bf16(sb, bgb[ks], acc, 0, 0, 0);
            }
            o[ebl] = acc; ss += (acc[0] * acc[0] + acc[1] * acc[1]) + (acc[2] * acc[2] + acc[3] * acc[3]);
        }
        ss += __shfl_xor(ss, 16); ss += __shfl_xor(ss, 32);
        if (fq == 0) sSS[eh * 64 + ib * 16 + fr] = ss;
        __syncthreads();
        const float rstd = rsqrtf((sSS[ib * 16 + fr] + sSS[64 + ib * 16 + fr]) * (1.0f / 128.0f) + 1e-6f);
        const bf16_t* G = (const bf16_t*)(p.ws + OFF_G); bf16_t* AG = (bf16_t*)(p.ws + OFF_AGLA);
#pragma unroll
        for (int ebl = 0; ebl < 4; ++ebl) {
            const int e0 = (eh * 4 + ebl) * 16 + fq * 4; const size_t ro = (size_t)(rowb + ib * 16 + fr) * 512 + h * 128 + e0;
            const u32x2 gg = *(const u32x2*)(G + ro); const f32x4 ng = *(const f32x4*)(p.in[11] + (size_t)l * 128 + e0);
            const float y0 = o[ebl][0] * rstd * ng[0] * silu(bf_lo(gg.x)), y1 = o[ebl][1] * rstd * ng[1] * silu(bf_hi(gg.x));
            const float y2 = o[ebl][2] * rstd * ng[2] * silu(bf_lo(gg.y)), y3 = o[ebl][3] * rstd * ng[3] * silu(bf_hi(gg.y));
            u32x2 ov; ov.x = cvt_pk_bf16(y0, y1); ov.y = cvt_pk_bf16(y2, y3);
            *(u32x2*)(AG + ro) = ov;
        }
    }
}

__device__ __forceinline__ void gla_scan_unit(bf16_t* KV, const float* DCH, int sample, int u) {
    const int chain = u >> 11, r = u & 2047;
    const int dir = chain & 1, h = (chain >> 1) & 3, sq = chain >> 3;
    const int N = sample ? 64 : 32, cg0 = sample ? (MP / 64 + sq * 64) : sq * 32;
    float S0 = 0.f, S1 = 0.f, S2 = 0.f, S3 = 0.f;
    for (int s0 = 0; s0 < N; s0 += 4) {
        u32x2 kv[4]; f32x4 dc[4]; bf16_t* ptr[4];
#pragma unroll
        for (int k = 0; k < 4; ++k) {
            const int n = dir ? (N - 1 - (s0 + k)) : (s0 + k); const size_t idx = (size_t)((cg0 + n) * 4 + h) * 2 + dir;
            ptr[k] = KV + idx * 8192 + r * 4; kv[k] = *(const u32x2*)ptr[k]; dc[k] = *(const f32x4*)(DCH + idx * 64 + (r & 15) * 4);
        }
#pragma unroll
        for (int k = 0; k < 4; ++k) {
            u32x2 o; o.x = cvt_pk_bf16(S0, S1); o.y = cvt_pk_bf16(S2, S3); *(u32x2*)ptr[k] = o;
            S0 = dc[k][0] * S0 + bf_lo(kv[k].x); S1 = dc[k][1] * S1 + bf_hi(kv[k].x); S2 = dc[k][2] * S2 + bf_lo(kv[k].y); S3 = dc[k][3] * S3 + bf_hi(kv[k].y);
        }
    }
}
__device__ __forceinline__ void phase_gla_scan(const Params& p) {
    bf16_t* KV = (bf16_t*)(p.ws + OFF_OF); const float* DCH = (const float*)(p.ws + OFF_DCH);
    int tid = threadIdx.x; asm volatile("" : "+v"(tid));
    for (int g = blockIdx.x * 512 + tid; g < 131072; g += gridDim.x * 512) {
        if (g < 65536) gla_scan_unit(KV, DCH, 1, g);
        else { gla_scan_unit(KV, DCH, 0, 2 * (g - 65536)); gla_scan_unit(KV, DCH, 0, 2 * (g - 65536) + 1); }
        gla_scan_unit(KV, DCH, 0, 131072 + g);
    }
}

#if NAIVE_GLA
__device__ __forceinline__ void gla_load_block(const Params& p, PG8_LAS unsigned char* lds, int l, int h, int dir, int rowb) {
    ldsf sq = (ldsf)lds, sk = sq + 4096, sa = sk + 4096, sv = sa + 4096;
    const bf16_t* QK = (const bf16_t*)(p.ws + OFF_QK); const bf16_t* V = (const bf16_t*)(p.ws + OFF_V); const float* LR = (const float*)(p.ws + OFF_LR);
    int tid = threadIdx.x; asm volatile("" : "+v"(tid));
    { const int t = tid >> 3, d8 = (tid & 7) * 8; const size_t o = (size_t)(rowb + t) * 512 + h * 64 + d8;
      const u32x4 q = *(const u32x4*)(QK + o), k = *(const u32x4*)(QK + o + 256);
      const unsigned qw[4] = {q.x, q.y, q.z, q.w}, kw[4] = {k.x, k.y, k.z, k.w};
#pragma unroll
      for (int i = 0; i < 4; ++i) { sq[t * 64 + d8 + 2 * i] = bf_lo(qw[i]) * 0.125f; sq[t * 64 + d8 + 2 * i + 1] = bf_hi(qw[i]) * 0.125f; sk[t * 64 + d8 + 2 * i] = bf_lo(kw[i]); sk[t * 64 + d8 + 2 * i + 1] = bf_hi(kw[i]); } }
    { const int t = tid >> 3, e16 = (tid & 7) * 16; const size_t o = (size_t)(rowb + t) * 512 + h * 128 + e16;
#pragma unroll
      for (int hh = 0; hh < 2; ++hh) { const u32x4 v = *(const u32x4*)(V + o + hh * 8); const unsigned vw[4] = {v.x, v.y, v.z, v.w};
#pragma unroll
          for (int i = 0; i < 4; ++i) { sv[t * 128 + e16 + hh * 8 + 2 * i] = bf_lo(vw[i]); sv[t * 128 + e16 + hh * 8 + 2 * i + 1] = bf_hi(vw[i]); } } }
    { const int d = tid & 63, tg = tid >> 6;
      const float* w2 = p.in[9] + ((size_t)(l * 2 + dir) * 16) * 256 + h * 64 + d; const float bias = p.in[10][(size_t)(l * 2 + dir) * 256 + h * 64 + d];
      float w[16];
#pragma unroll
      for (int r = 0; r < 16; ++r) w[r] = w2[r * 256];
#pragma unroll
      for (int i = 0; i < 8; ++i) { const int t = tg * 8 + i; const float* lr = LR + (size_t)(rowb + t) * 32 + dir * 16; float z = bias;
#pragma unroll
          for (int r4 = 0; r4 < 4; ++r4) { const f32x4 x = *(const f32x4*)(lr + r4 * 4); z += x[0] * w[r4 * 4] + x[1] * w[r4 * 4 + 1] + x[2] * w[r4 * 4 + 2] + x[3] * w[r4 * 4 + 3]; }
          const float ls = fminf(z, 0.f) - log1pf(__expf(-fabsf(z)));
          sa[t * 64 + d] = __expf(ls * 0.0625f); } }
}
__device__ __forceinline__ void phase_gla_naive(const Params& p, PG8_LAS unsigned char* lds, int l, int item) {
    ldsf sq = (ldsf)lds, sk = sq + 4096, sa = sk + 4096, sv = sa + 4096, so = sv + 8192;
    float* OF = (float*)(p.ws + OFF_OF); const bf16_t* G = (const bf16_t*)(p.ws + OFF_G); bf16_t* AG = (bf16_t*)(p.ws + OFF_AGLA);
    const int seq = item >> 2, h = item & 3;
    const int row0 = seq < 16 ? seq * 2048 : MP + (seq - 16) * 4096, T = seq < 16 ? 2048 : 4096, nb = T >> 6;
    int tid = threadIdx.x; asm volatile("" : "+v"(tid)); const int e = tid >> 2, dg = tid & 3, lane = tid & 63, wid = tid >> 6;
    float S[16];
#pragma unroll
    for (int i = 0; i < 16; ++i) S[i] = 0.f;
    for (int blk = 0; blk < nb; ++blk) {
        const int rowb = row0 + blk * 64;
        gla_load_block(p, lds, l, h, 0, rowb);
        __syncthreads();
        for (int t = 0; t < 64; ++t) {
            const float vv = sv[t * 128 + e]; float po = 0.f;
#pragma unroll
            for (int i4 = 0; i4 < 4; ++i4) {
                const f32x4 a = *(const PG8_LAS f32x4*)(sa + t * 64 + dg * 16 + i4 * 4), k = *(const PG8_LAS f32x4*)(sk + t * 64 + dg * 16 + i4 * 4), q = *(const PG8_LAS f32x4*)(sq + t * 64 + dg * 16 + i4 * 4);
#pragma unroll
                for (int j = 0; j < 4; ++j) { S[i4 * 4 + j] = a[j] * S[i4 * 4 + j] + k[j] * vv; po += q[j] * S[i4 * 4 + j]; }
            }
            po += __shfl_xor(po, 1); po += __shfl_xor(po, 2);
            if (dg == 0) so[t * 128 + e] = po;
        }
        __syncthreads();
#pragma unroll
        for (int i = 0; i < 16; ++i) { const int idx = i * 512 + tid; const int t = idx >> 7, ee = idx & 127; OF[(size_t)(rowb + t) * 512 + h * 128 + ee] = so[idx]; }
        __syncthreads();
    }
#pragma unroll
    for (int i = 0; i < 16; ++i) S[i] = 0.f;
    const float ng0 = p.in[11][(size_t)l * 128 + lane], ng1 = p.in[11][(size_t)l * 128 + 64 + lane];
    for (int blk = nb - 1; blk >= 0; --blk) {
        const int rowb = row0 + blk * 64;
        gla_load_block(p, lds, l, h, 1, rowb);
        __syncthreads();
        for (int t = 63; t >= 0; --t) {
            const float vv = sv[t * 128 + e]; float po = 0.f;
#pragma unroll
            for (int i4 = 0; i4 < 4; ++i4) {
                const f32x4 a = *(const PG8_LAS f32x4*)(sa + t * 64 + dg * 16 + i4 * 4), k = *(const PG8_LAS f32x4*)(sk + t * 64 + dg * 16 + i4 * 4), q = *(const PG8_LAS f32x4*)(sq + t * 64 + dg * 16 + i4 * 4);
#pragma unroll
                for (int j = 0; j < 4; ++j) { const float sd = a[j] * S[i4 * 4 + j]; po += q[j] * sd; S[i4 * 4 + j] = sd + k[j] * vv; }
            }
            po += __shfl_xor(po, 1); po += __shfl_xor(po, 2);
            if (dg == 0) so[t * 128 + e] = po;
        }
        __syncthreads();
#pragma unroll
        for (int i = 0; i < 8; ++i) {
            const int t = wid * 8 + i; const size_t ro = (size_t)(rowb + t) * 512 + h * 128;
            const float o0 = so[t * 128 + lane] + OF[ro + lane], o1 = so[t * 128 + 64 + lane] + OF[ro + 64 + lane];
            const float ss = wave_sum(o0 * o0 + o1 * o1); const float rstd = rsqrtf(ss * (1.0f / 128.0f) + 1e-6f);
            const float g0 = bf2f(G[ro + lane]), g1 = bf2f(G[ro + 64 + lane]);
            const float y0 = o0 * rstd * ng0 * silu(g0), y1 = o1 * rstd * ng1 * silu(g1);
            AG[ro + lane] = (bf16_t)(cvt_pk_bf16(y0, 0.f) & 0xffffu); AG[ro + 64 + lane] = (bf16_t)(cvt_pk_bf16(y1, 0.f) & 0xffffu);
        }
        __syncthreads();
    }
}

#endif
__device__ __forceinline__ void phase_xa(const Params& p) {
    const bf16_t* Q = (const bf16_t*)(p.ws + OFF_QK); const bf16_t* KM = (const bf16_t*)(p.ws + OFF_KM); const bf16_t* VT = (const bf16_t*)(p.ws + OFF_VT);
    bf16_t* AO = (bf16_t*)(p.ws + OFF_OF);
    int tid = threadIdx.x; asm volatile("" : "+v"(tid)); const int lane = tid & 63, wid = tid >> 6, fr = lane & 15, fq = lane >> 4;
    for (int item = blockIdx.x; item < 768; item += gridDim.x) {
        const int pm = item >> 2, h = item & 3;
        const int r0 = pm * 256 + wid * 32;
        const int b = r0 < MP ? (r0 >> 11) : 16 + ((r0 - MP) >> 12);
        const int mb = b * 256;
        f32x4 acc[16][2];
#pragma unroll
        for (int kb = 0; kb < 16; ++kb) { acc[kb][0] = (f32x4){0.f, 0.f, 0.f, 0.f}; acc[kb][1] = (f32x4){0.f, 0.f, 0.f, 0.f}; }
        const bf16_t* qp = Q + (size_t)(r0 + fr) * D + h * 256 + fq * 8;
        const bf16_t* kp = KM + (size_t)(mb + fr) * D + h * 256 + fq * 8;
#pragma unroll 1
        for (int ks = 0; ks < 8; ++ks) {
            const bf16x8 q0 = *(const bf16x8*)(qp + ks * 32), q1 = *(const bf16x8*)(qp + 16 * D + ks * 32);
#pragma unroll
            for (int kg = 0; kg < 4; ++kg) {
                bf16x8 kf[4];
#pragma unroll
                for (int k4 = 0; k4 < 4; ++k4) kf[k4] = *(const bf16x8*)(kp + (size_t)(kg * 4 + k4) * 16 * D + ks * 32);
#pragma unroll
                for (int k4 = 0; k4 < 4; ++k4) {
                    acc[kg * 4 + k4][0] = __builtin_amdgcn_mfma_f32_16x16x32_bf16(kf[k4], q0, acc[kg * 4 + k4][0], 0, 0, 0);
                    acc[kg * 4 + k4][1] = __builtin_amdgcn_mfma_f32_16x16x32_bf16(kf[k4], q1, acc[kg * 4 + k4][1], 0, 0, 0);
                }
                asm volatile("" ::: "memory");
            }
        }
        float inv[2]; bf16x8 pf[8][2];
#pragma unroll
        for (int rb = 0; rb < 2; ++rb) {
            float mx = -3.0e38f;
#pragma unroll
            for (int kb = 0; kb < 16; ++kb)
#pragma unroll
                for (int j = 0; j < 4; ++j) mx = fmaxf(mx, acc[kb][rb][j]);
            mx = fmaxf(mx, __shfl_xor(mx, 16)); mx = fmaxf(mx, __shfl_xor(mx, 32));
            float sum = 0.f;
            const float c = 0.0625f * 1.44269504088896f;
#pragma unroll
            for (int kb = 0; kb < 16; ++kb)
#pragma unroll
                for (int j = 0; j < 4; ++j) { const float e = exp2f((acc[kb][rb][j] - mx) * c); acc[kb][rb][j] = e; sum += e; }
            sum += __shfl_xor(sum, 16); sum += __shfl_xor(sum, 32);
            inv[rb] = 1.0f / sum;
#pragma unroll
            for (int s = 0; s < 8; ++s) {
                typedef unsigned u4v __attribute__((ext_vector_type(4)));
                u4v w; w.x = cvt_pk_bf16(acc[2 * s][rb][0], acc[2 * s][rb][1]); w.y = cvt_pk_bf16(acc[2 * s][rb][2], acc[2 * s][rb][3]);
                w.z = cvt_pk_bf16(acc[2 * s + 1][rb][0], acc[2 * s + 1][rb][1]); w.w = cvt_pk_bf16(acc[2 * s + 1][rb][2], acc[2 * s + 1][rb][3]);
                pf[s][rb] = __builtin_bit_cast(bf16x8, w);
            }
        }
        const bf16_t* vp = VT + (size_t)(h * 256 + fr) * NMEM + mb + fq * 4;
#pragma unroll 1
        for (int db = 0; db < 16; ++db) {
            f32x4 o0 = (f32x4){0.f, 0.f, 0.f, 0.f}, o1 = (f32x4){0.f, 0.f, 0.f, 0.f};
#pragma unroll
            for (int s = 0; s < 8; ++s) {
                const u32x2 a = *(const u32x2*)(vp + (size_t)db * 16 * NMEM + s * 32), c = *(const u32x2*)(vp + (size_t)db * 16 * NMEM + s * 32 + 16);
                typedef unsigned u4v __attribute__((ext_vector_type(4)));
                u4v w; w.x = a.x; w.y = a.y; w.z = c.x; w.w = c.y;
                const bf16x8 vf = __builtin_bit_cast(bf16x8, w);
                o0 = __builtin_amdgcn_mfma_f32_16x16x32_bf16(vf, pf[s][0], o0, 0, 0, 0);
                o1 = __builtin_amdgcn_mfma_f32_16x16x32_bf16(vf, pf[s][1], o1, 0, 0, 0);
            }
            u32x2 w0, w1; w0.x = cvt_pk_bf16(o0[0] * inv[0], o0[1] * inv[0]); w0.y = cvt_pk_bf16(o0[2] * inv[0], o0[3] * inv[0]);
            w1.x = cvt_pk_bf16(o1[0] * inv[1], o1[1] * inv[1]); w1.y = cvt_pk_bf16(o1[2] * inv[1], o1[3] * inv[1]);
            *(u32x2*)(AO + (size_t)(r0 + fr) * D + h * 256 + db * 16 + fq * 4) = w0;
            *(u32x2*)(AO + (size_t)(r0 + 16 + fr) * D + h * 256 + db * 16 + fq * 4) = w1;
        }
    }
}

__global__ void __launch_bounds__(512, 2) mega(Params p) {
    extern __shared__ __attribute__((aligned(16))) unsigned char lds_raw[];
    PG8_LAS unsigned char* lds = (PG8_LAS unsigned char*)lds_raw;
    unsigned char* ws = p.ws;
    bf16_t* Wb = (bf16_t*)(ws + OFF_W); bf16_t* XB = (bf16_t*)(ws + OFF_XB); bf16_t* HB = (bf16_t*)(ws + OFF_HC);
    for (int ph = p.ph_lo; ph < p.ph_hi; ++ph) {
        const int l = ph / NPH, s = ph % NPH;
#ifdef ONLY_S
        if (!(ONLY_S)) continue;
#endif
        if (s == 0) {
            if (l > 0) continue;
            phase_prologue(p);
            phase_wprep(p, lds, 0);
        } else if (s == 1 || s == 16) {
            EpiSwiglu e{HB};
            run_gemm<EpiSwiglu>(lds, XB, Wb + (s == 1 ? W_GU1 : W_GU2), M, 5632, 1024, e, 0);
        } else if (s == 2 || s == 10 || s == 14 || s == 17) {
            const bf16_t* A; const bf16_t* Bt; int K; float sc;
            if (s == 2)       { A = HB; Bt = Wb + W_D1; K = DFF; sc = 0.5f; }
            else if (s == 10) { A = (const bf16_t*)(ws + OFF_HC); Bt = Wb + W_OUT; K = 1024; sc = 1.0f; }
            else if (s == 14) { A = (const bf16_t*)(ws + OFF_OF); Bt = Wb + W_O; K = 1024; sc = 1.0f; }
            else              { A = HB; Bt = Wb + W_D2; K = DFF; sc = 0.5f; }
            EpiResid e{p.out, sc};
            run_gemm<EpiResid>(lds, A, Bt, M, 1024, K, e, 0);
        } else if (s == 3 || s == 11 || s == 15 || s == 18) {
            phase_ln(p, l, s == 3 ? 0 : (s == 11 ? 1 : (s == 15 ? 2 : 3)));
            if (s == 18 && l + 1 < NL) phase_wprep(p, lds, l + 1);
        } else if (s == 4 || s == 8 || s == 12) {
            const int ng = s == 4 ? 1 : (s == 8 ? 2 : 3);
            for (int gi = 0; gi < ng; ++gi) {
                const bf16_t* A; const bf16_t* Bt; int Mr, N, K, cs = 0; EpiRoute e{nullptr, 0, 0, 0, nullptr, -1};
                if (s == 4) { A = XB; Bt = Wb + W_INA; Mr = M; N = 3328; K = 1024; e.base = (bf16_t*)(ws + OFF_HC); e.ld = 512; e.tpb = 2; e.bstride = (size_t)M * 512; e.lr = (float*)(ws + OFF_LR); e.lr_tile = 12; }
                else if (s == 8) {
                    if (gi == 0) { A = (const bf16_t*)(ws + OFF_GB); Bt = Wb + W_CO; e.base = (bf16_t*)(ws + OFF_QK); }
                    else         { A = (const bf16_t*)(ws + OFF_AGLA); Bt = Wb + W_GO; e.base = (bf16_t*)(ws + OFF_OF); }
                    Mr = M; N = 1024; K = 512; e.ld = 1024;
                } else {
                    if (gi == 0)      { A = XB; Bt = Wb + W_Q; Mr = M; N = 1024; e.base = (bf16_t*)(ws + OFF_QK); e.ld = 1024; }
                    else if (gi == 1) { A = (const bf16_t*)(ws + OFF_MEMB); Bt = Wb + W_K; Mr = NMEM; N = 1024; e.base = (bf16_t*)(ws + OFF_KM); e.ld = 1024; }
                    else              { A = Wb + W_V; Bt = (const bf16_t*)(ws + OFF_MEMB); Mr = 1024; N = NMEM; e.base = (bf16_t*)(ws + OFF_VT); e.ld = NMEM; cs = (int)gridDim.x - 80; }
                    K = 1024;
                }
                run_gemm<EpiRoute>(lds, A, Bt, Mr, N, K, e, cs);
            }
        }
#if NAIVE_GLA
        else if (s == 5) {
            if (blockIdx.x < 80) phase_gla_naive(p, lds, l, (int)blockIdx.x);
            else phase_conv(p, l, (int)blockIdx.x - 80, (int)gridDim.x - 80);
        } else if (s == 6 || s == 7) {
        }
#else
        else if (s == 5) {
            for (int it = blockIdx.x; it < 3072; it += gridDim.x) gla_chunk<1>(p, lds, l, it);
            phase_conv(p, l, (int)blockIdx.x, (int)gridDim.x);
        } else if (s == 6) {
            phase_gla_scan(p);
        } else if (s == 7) {
            for (int it = blockIdx.x; it < 3072; it += gridDim.x) gla_chunk<3>(p, lds, l, it);
        }
#endif
        else if (s == 9) {
            EpiMerge e{(const bf16_t*)(ws + OFF_QK), (const bf16_t*)(ws + OFF_OF), (bf16_t*)(ws + OFF_HC)};
            run_gemm<EpiMerge>(lds, XB, Wb + W_INM, M, 2048, 1024, e, 0);
        } else if (s == 13) {
            phase_xa(p);
        }
        if (ph + 1 < p.ph_hi) { if (p.coop) cg::this_grid().sync(); }
    }
}
}

extern "C" void kernel_launch(void* const* d_in, const int* in_sizes, int n_in, void* d_out, int out_size, void* d_ws, size_t ws_size, hipStream_t stream) {
    static int grid = 0;
    if (grid == 0) {
        if (n_in != 21 || ws_size < mk::WS_END) { fprintf(stderr, "kernel_launch: unexpected n_in %d / ws %zu (need %zu)\n", n_in, ws_size, (size_t)mk::WS_END); grid = -1; return; }
        int dev = 0, cus = 0, per_cu = 0;
        hipGetDevice(&dev); hipDeviceGetAttribute(&cus, hipDeviceAttributeMultiprocessorCount, dev);
        if (hipFuncSetAttribute((const void*)mk::mega, hipFuncAttributeMaxDynamicSharedMemorySize, mk::LDS_BYTES) != hipSuccess) { fprintf(stderr, "hipFuncSetAttribute failed\n"); grid = -1; return; }
        if (hipOccupancyMaxActiveBlocksPerMultiprocessor(&per_cu, (const void*)mk::mega, 512, mk::LDS_BYTES) != hipSuccess || per_cu < 1) { fprintf(stderr, "occupancy query: %d\n", per_cu); per_cu = 1; }
        (void)hipGetLastError();
        grid = cus * per_cu;
    }
    if (grid < 0) return;
    mk::Params p{};
    for (int i = 0; i < 21; ++i) p.in[i] = (const float*)d_in[i];
    p.out = (float*)d_out; p.ws = (unsigned char*)d_ws; p.ph_lo = 0; p.ph_hi = mk::NL * mk::NPH; p.coop = 1; p.pad = 0;
    void* args[] = {&p};
    hipError_t e = hipLaunchCooperativeKernel((const void*)mk::mega, dim3(grid), dim3(512), args, mk::LDS_BYTES, stream);
    if (e != hipSuccess) fprintf(stderr, "cooperative launch failed: %s (grid %d)\n", hipGetErrorString(e), grid);
}
```
